# Optimizing an MI355X kernel written in HIP

```python
import jax, jax.numpy as jnp
from jax import lax
import numpy as np

D_MODEL = 1024
BATCH = 32
SEQ = 2048
DEPTH = 2
DEC_BATCH = 16
DEC_SEQ = 2048
PAST_LEN = 128

NORM_EPS = 1e-6
W_LRU = 256
W_MLA = 512
W_GLA = 256
LRU_BLOCKS = 8
LRU_BLOCK = W_LRU // LRU_BLOCKS
CONV_W = 4
CONV_LEFT = 2
CONV_RIGHT = 1
LRU_C = 8.0
MLA_HEADS = 4
QK_NOPE = 128
QK_ROPE = 64
QK_HEAD = QK_NOPE + QK_ROPE
V_HEAD = W_MLA // MLA_HEADS
Q_RANK = 256
KV_RANK = 128
ROPE_THETA = 10000.0
Q_BLOCK = 128
GLA_HEADS = 4
GLA_DK = 32
GLA_DV = W_GLA // GLA_HEADS
GLA_GATE_RANK = 16
GLA_TAU = 16.0
GLA_CHUNK = 64
D_FF = -(-8 * D_MODEL // (3 * 256)) * 256
IN_SPLITS = (W_LRU, W_LRU,
             Q_RANK, KV_RANK, QK_ROPE,
             GLA_HEADS * GLA_DK, GLA_HEADS * GLA_DK, W_GLA,
             GLA_GATE_RANK, GLA_GATE_RANK,
             W_GLA)
D_IN = sum(IN_SPLITS)

kernel_name = 'hymba_style_lru_mla_gla_encoder'


def rms_norm(x, g):
    xf = x.astype(jnp.float32)
    y = xf * lax.rsqrt(jnp.mean(xf * xf, axis=-1, keepdims=True) + NORM_EPS)
    return (y * g.astype(jnp.float32)).astype(x.dtype)


def _split_points():
    return [int(v) for v in np.cumsum(IN_SPLITS)[:-1]]


def _rotary_tables(seq_len, dtype):
    half = QK_ROPE // 2
    inv = 1.0 / (ROPE_THETA ** (jnp.arange(half, dtype=jnp.float32) * 2.0 / QK_ROPE))
    ang = jnp.arange(seq_len, dtype=jnp.float32)[:, None] * inv[None, :]
    return jnp.cos(ang).astype(dtype), jnp.sin(ang).astype(dtype)


def _rotary(x, cos, sin):
    x1, x2 = jnp.split(x, 2, axis=-1)
    return jnp.concatenate([x1 * cos - x2 * sin, x2 * cos + x1 * sin], axis=-1)


def _centred_dwconv(x, w, b):
    S = x.shape[1]
    xp = jnp.pad(x, ((0, 0), (CONV_LEFT, CONV_RIGHT), (0, 0)))
    y = xp[:, 0:S] * w[0]
    for j in range(1, CONV_W):
        y = y + xp[:, j:j + S] * w[j]
    return y + b


def _block_diag(x, w, b):
    xb = x.reshape(x.shape[:-1] + (LRU_BLOCKS, LRU_BLOCK))
    return jnp.einsum('bsnc,ncd->bsnd', xb, w).reshape(x.shape) + b


def _linear_combine(left, right):
    a_l, b_l = left
    a_r, b_r = right
    return a_l * a_r, a_r * b_l + b_r


def _rg_lru(x, w_a, b_a, w_x, b_x, lam, reverse):
    f32 = jnp.float32
    r = jax.nn.sigmoid(_block_diag(x, w_a, b_a).astype(f32))
    i = jax.nn.sigmoid(_block_diag(x, w_x, b_x).astype(f32))
    log_a = -LRU_C * r * jax.nn.softplus(-lam.astype(f32))
    a = jnp.exp(log_a)
    u = jnp.sqrt(-jnp.expm1(2.0 * log_a)) * (i * x.astype(f32))
    _, h = lax.associative_scan(_linear_combine, (a, u), axis=1, reverse=reverse)
    return h.astype(x.dtype)


def _mla(c_q, c_kv, k_rope, g_cq, w_uq, g_ckv, w_ukv, g_q, g_k, cos, sin):
    B, S, _ = c_q.shape
    q = jnp.einsum('bsr,re->bse', rms_norm(c_q, g_cq), w_uq).reshape(B, S, MLA_HEADS, QK_HEAD)
    kv = jnp.einsum('bsr,re->bse', rms_norm(c_kv, g_ckv), w_ukv).reshape(B, S, MLA_HEADS, QK_NOPE + V_HEAD)
    k_nope, v = kv[..., :QK_NOPE], kv[..., QK_NOPE:]
    k_r = jnp.broadcast_to(k_rope[:, :, None, :], (B, S, MLA_HEADS, QK_ROPE))
    k = jnp.concatenate([k_nope, k_r], axis=-1)
    q = rms_norm(q, g_q)
    k = rms_norm(k, g_k)
    cs, sn = cos[:, None, :], sin[:, None, :]
    q = jnp.concatenate([q[..., :QK_NOPE], _rotary(q[..., QK_NOPE:], cs, sn)], axis=-1)
    k = jnp.concatenate([k[..., :QK_NOPE], _rotary(k[..., QK_NOPE:], cs, sn)], axis=-1)
    q = q.transpose(0, 2, 1, 3)
    k = k.transpose(0, 2, 1, 3)
    v = v.transpose(0, 2, 1, 3)
    n_blk = S // Q_BLOCK
    qb = q.reshape(B, MLA_HEADS, n_blk, Q_BLOCK, QK_HEAD).transpose(2, 0, 1, 3, 4)
    scale = QK_HEAD ** -0.5

    def attend(q_blk):
        s = jnp.einsum('bhqd,bhkd->bhqk', q_blk, k).astype(jnp.float32) * scale
        p = jax.nn.softmax(s, axis=-1)
        return jnp.einsum('bhqk,bhkd->bhqd', p.astype(v.dtype), v)

    o = lax.map(attend, qb)
    return o.transpose(1, 0, 3, 2, 4).reshape(B, S, W_MLA)


def _gla_chunked(q, k, v, log_a):
    B, H, S, dk = q.shape
    dv = v.shape[-1]
    n = S // GLA_CHUNK

    def chunks(t):
        return t.reshape(B, H, n, GLA_CHUNK, t.shape[-1])

    q, k, v, log_a = chunks(q), chunks(k), chunks(v), chunks(log_a)
    b = jnp.cumsum(log_a, axis=3)
    b_last = b[:, :, :, -1:, :]
    q_dec = q * jnp.exp(b)
    k_inv = k * jnp.exp(-b)
    k_end = k * jnp.exp(b_last - b)
    lower_tri = jnp.tril(jnp.ones((GLA_CHUNK, GLA_CHUNK), q.dtype))
    scores = jnp.einsum('bhnqd,bhnkd->bhnqk', q_dec, k_inv) * lower_tri
    o_intra = jnp.einsum('bhnqk,bhnkv->bhnqv', scores, v)
    chunk_update = jnp.einsum('bhnkd,bhnkv->nbhdv', k_end, v)
    chunk_decay = jnp.exp(jnp.moveaxis(b_last[:, :, :, 0, :], 2, 0))

    def step(state, inp):
        decay, upd = inp
        return decay[..., None] * state + upd, state

    init = jnp.zeros((B, H, dk, dv), q.dtype)
    _, prev_state = lax.scan(step, init, (chunk_decay, chunk_update))
    o_inter = jnp.einsum('bhnqd,nbhdv->bhnqv', q_dec, prev_state)
    return (o_intra + o_inter).reshape(B, H, S, dv)


def _gla(q, k, v, gf, gb, og, wa2_f, ba2_f, wa2_b, ba2_b, g_o):
    B, S, _ = q.shape
    f32 = jnp.float32

    def heads(t, d):
        return t.reshape(B, S, GLA_HEADS, d).transpose(0, 2, 1, 3).astype(f32)

    qh = heads(q, GLA_DK) * GLA_DK ** -0.5
    kh = heads(k, GLA_DK)
    vh = heads(v, GLA_DV)
    la_f = heads(jax.nn.log_sigmoid((jnp.einsum('bsr,re->bse', gf, wa2_f) + ba2_f).astype(f32)) / GLA_TAU, GLA_DK)
    la_b = heads(jax.nn.log_sigmoid((jnp.einsum('bsr,re->bse', gb, wa2_b) + ba2_b).astype(f32)) / GLA_TAU, GLA_DK)
    o_f = _gla_chunked(qh, kh, vh, la_f)

    def flip(t):
        return jnp.flip(t, axis=2)

    o_b = flip(_gla_chunked(flip(qh), flip(kh), flip(vh), flip(la_b)))
    o = rms_norm(o_f + o_b, g_o)
    o = o.transpose(0, 2, 1, 3).reshape(B, S, W_GLA).astype(og.dtype)
    return o * jax.nn.silu(og)


def hybrid_layer(x, cos, sin, g_mix, w_in, conv_w, conv_b,
                 lru_wa_f, lru_ba_f, lru_wx_f, lru_bx_f, lru_lam_f,
                 lru_wa_b, lru_ba_b, lru_wx_b, lru_bx_b, lru_lam_b,
                 mla_g_cq, mla_w_uq, mla_g_ckv, mla_w_ukv, mla_g_q, mla_g_k,
                 gla_wa2_f, gla_ba2_f, gla_wa2_b, gla_ba2_b, gla_g_o,
                 w_out, g_ffn, w_ffn_in, w_ffn_out):
    h = rms_norm(x, g_mix)
    z = jnp.einsum('bsd,de->bse', h, w_in)
    (lru_in, lru_gate, c_q, c_kv, k_rope, gla_q, gla_k, gla_v,
     gla_gf, gla_gb, gla_og) = jnp.split(z, _split_points(), axis=-1)
    u = _centred_dwconv(lru_in, conv_w, conv_b)
    h_lru = (_rg_lru(u, lru_wa_f, lru_ba_f, lru_wx_f, lru_bx_f, lru_lam_f, reverse=False)
             + _rg_lru(u, lru_wa_b, lru_ba_b, lru_wx_b, lru_bx_b, lru_lam_b, reverse=True))
    o_lru = h_lru * jax.nn.gelu(lru_gate)
    o_mla = _mla(c_q, c_kv, k_rope, mla_g_cq, mla_w_uq, mla_g_ckv, mla_w_ukv, mla_g_q, mla_g_k, cos, sin)
    o_gla = _gla(gla_q, gla_k, gla_v, gla_gf, gla_gb, gla_og, gla_wa2_f, gla_ba2_f, gla_wa2_b, gla_ba2_b, gla_g_o)
    mixed = jnp.concatenate([o_lru, o_mla, o_gla], axis=-1)
    x = x + jnp.einsum('bse,ed->bsd', mixed, w_out)
    h = rms_norm(x, g_ffn)
    gate, up = jnp.split(jnp.einsum('bsd,df->bsf', h, w_ffn_in), 2, axis=-1)
    return x + jnp.einsum('bsf,fd->bsd', jax.nn.silu(gate) * up, w_ffn_out)


def setup_inputs(seed: int = 0) -> dict:
    key = jax.random.key(seed)
    keys = iter(jax.random.split(key, 48))
    f32 = jnp.float32
    L = DEPTH

    def normal(shape, scale):
        return scale * jax.random.normal(next(keys), shape, f32)

    def gain(shape):
        return 1.0 + 0.02 * jax.random.normal(next(keys), shape, f32)

    def lru_lambda():
        a = jax.random.uniform(next(keys), (L, W_LRU), f32, 0.9, 0.999)
        s = a ** (1.0 / LRU_C)
        return jnp.log(s) - jnp.log1p(-s)

    return {
        'x_prompt': normal((BATCH, SEQ, D_MODEL), 1.0),
        'x_sample': normal((DEC_BATCH, DEC_SEQ, D_MODEL), 1.0),
        'g_mix': gain((L, D_MODEL)),
        'w_in': normal((L, D_MODEL, D_IN), D_MODEL ** -0.5),
        'conv_w': normal((L, CONV_W, W_LRU), CONV_W ** -0.5),
        'conv_b': normal((L, W_LRU), 0.02),
        'lru_wa_f': normal((L, LRU_BLOCKS, LRU_BLOCK, LRU_BLOCK), LRU_BLOCK ** -0.5),
        'lru_ba_f': normal((L, W_LRU), 0.02),
        'lru_wx_f': normal((L, LRU_BLOCKS, LRU_BLOCK, LRU_BLOCK), LRU_BLOCK ** -0.5),
        'lru_bx_f': normal((L, W_LRU), 0.02),
        'lru_lam_f': lru_lambda(),
        'lru_wa_b': normal((L, LRU_BLOCKS, LRU_BLOCK, LRU_BLOCK), LRU_BLOCK ** -0.5),
        'lru_ba_b': normal((L, W_LRU), 0.02),
        'lru_wx_b': normal((L, LRU_BLOCKS, LRU_BLOCK, LRU_BLOCK), LRU_BLOCK ** -0.5),
        'lru_bx_b': normal((L, W_LRU), 0.02),
        'lru_lam_b': lru_lambda(),
        'mla_g_cq': gain((L, Q_RANK)),
        'mla_w_uq': normal((L, Q_RANK, MLA_HEADS * QK_HEAD), Q_RANK ** -0.5),
        'mla_g_ckv': gain((L, KV_RANK)),
        'mla_w_ukv': normal((L, KV_RANK, MLA_HEADS * (QK_NOPE + V_HEAD)), KV_RANK ** -0.5),
        'mla_g_q': gain((L, QK_HEAD)),
        'mla_g_k': gain((L, QK_HEAD)),
        'gla_wa2_f': normal((L, GLA_GATE_RANK, GLA_HEADS * GLA_DK), GLA_GATE_RANK ** -0.5),
        'gla_ba2_f': normal((L, GLA_HEADS * GLA_DK), 0.02),
        'gla_wa2_b': normal((L, GLA_GATE_RANK, GLA_HEADS * GLA_DK), GLA_GATE_RANK ** -0.5),
        'gla_ba2_b': normal((L, GLA_HEADS * GLA_DK), 0.02),
        'gla_g_o': gain((L, GLA_DV)),
        'w_out': normal((L, D_MODEL, D_MODEL), D_MODEL ** -0.5),
        'g_ffn': gain((L, D_MODEL)),
        'w_ffn_in': normal((L, D_MODEL, 2 * D_FF), D_MODEL ** -0.5),
        'w_ffn_out': normal((L, D_FF, D_MODEL), D_FF ** -0.5),
    }


def reference(x_prompt, x_sample, g_mix, w_in, conv_w, conv_b,
              lru_wa_f, lru_ba_f, lru_wx_f, lru_bx_f, lru_lam_f,
              lru_wa_b, lru_ba_b, lru_wx_b, lru_bx_b, lru_lam_b,
              mla_g_cq, mla_w_uq, mla_g_ckv, mla_w_ukv, mla_g_q, mla_g_k,
              gla_wa2_f, gla_ba2_f, gla_wa2_b, gla_ba2_b, gla_g_o,
              w_out, g_ffn, w_ffn_in, w_ffn_out):
    params = (g_mix, w_in, conv_w, conv_b,
              lru_wa_f, lru_ba_f, lru_wx_f, lru_bx_f, lru_lam_f,
              lru_wa_b, lru_ba_b, lru_wx_b, lru_bx_b, lru_lam_b,
              mla_g_cq, mla_w_uq, mla_g_ckv, mla_w_ukv, mla_g_q, mla_g_k,
              gla_wa2_f, gla_ba2_f, gla_wa2_b, gla_ba2_b, gla_g_o,
              w_out, g_ffn, w_ffn_in, w_ffn_out)

    def trunk(x):
        cos, sin = _rotary_tables(x.shape[1], x.dtype)
        for l in range(DEPTH):
            x = hybrid_layer(x, cos, sin, *[p[l] for p in params])
        return x

    y_prompt = trunk(x_prompt)
    y_sample = trunk(x_sample)
    return (y_prompt, y_sample)
```

```cpp
#include <hip/hip_runtime.h>
#include <hip/hip_cooperative_groups.h>
#include <cstdio>
#include <cstdint>
namespace cg = cooperative_groups;

#ifndef MULTI_LAUNCH
#define MULTI_LAUNCH 0
#endif

typedef unsigned short u16;
typedef __attribute__((ext_vector_type(8))) short bf16x8;
typedef __attribute__((ext_vector_type(16))) float f32x16;
typedef unsigned u32x4 __attribute__((ext_vector_type(4)));
typedef __bf16 bf16x2_t __attribute__((ext_vector_type(2)));
typedef float f32x2_t __attribute__((ext_vector_type(2)));
#define DI __device__ __forceinline__
#define MFMA(a, b, c) __builtin_amdgcn_mfma_f32_32x32x16_bf16((a), (b), (c), 0, 0, 0)

constexpr int NSEQ = 48, SEQ = 2048, T = NSEQ * SEQ;
constexpr int DM = 1024, DIN = 1760, DFF = 2816;
constexpr float EPS = 1e-6f;

constexpr size_t WIN = 0, WQKV = 1835008, WOUT = 2523136, WFI = 3571712, WFO = 9338880, WLAYER = 12222464;
constexpr size_t OFF_WB = 0;
constexpr size_t OFF_ROPE = 2 * WLAYER * 2;
constexpr size_t OFF_CTR = OFF_ROPE + 2048 * 32 * 8;
constexpr size_t OFF_H = OFF_CTR + 256;
constexpr size_t OFF_Z = OFF_H + (size_t)T * 1024 * 2;
constexpr size_t OFF_Q = OFF_Z + (size_t)T * 1760 * 2;
constexpr size_t OFF_K = OFF_Q + (size_t)T * 768 * 2;
constexpr size_t OFF_VT = OFF_K + (size_t)T * 768 * 2;
constexpr size_t OFF_GT = OFF_VT + (size_t)T * 512 * 2;
constexpr size_t WS_END = OFF_GT + (size_t)T * 256 * 2;
constexpr size_t OFF_HID = OFF_Z;
constexpr size_t OFF_XB = OFF_HID + (size_t)T * 2816 * 2;
constexpr size_t OFF_SSQ = WS_END;
constexpr size_t OFF_SQL = OFF_SSQ + 4 * (size_t)T * 4;
constexpr size_t OFF_BAR = OFF_SQL + 4 * (size_t)T * 4;
constexpr size_t WS_NEED = OFF_BAR + 16384;
static_assert(OFF_XB + (size_t)T * 1024 * 2 <= WS_END, "xb alias");
static_assert(OFF_HID + (size_t)T * 2816 * 2 <= OFF_VT, "hidden alias");

constexpr int SMEM_BYTES = 131072;
constexpr int LDS_BYTES = SMEM_BYTES + 64;
#define LAS __attribute__((address_space(3)))
typedef float f32x4v __attribute__((ext_vector_type(4)));
constexpr int NPHASE = 21;

struct Params {
  const float* in[31];
  float* out;
  char* ws;
};

DI int get_tid() { int t = threadIdx.x; asm volatile("" : "+v"(t)); return t; }
DI unsigned pack2(float a, float b) {
  f32x2_t v = {a, b};
  bf16x2_t r = __builtin_convertvector(v, bf16x2_t);
  return __builtin_bit_cast(unsigned, r);
}
DI u16 f2bf(float a) { return (u16)(pack2(a, 0.f) & 0xffffu); }
DI float bf2f(u16 v) { return __uint_as_float(((unsigned)v) << 16); }
DI float bflo(unsigned v) { return __uint_as_float(v << 16); }
DI float bfhi(unsigned v) { return __uint_as_float(v & 0xffff0000u); }
DI float wave_sum(float v) {
#pragma unroll
  for (int o = 32; o; o >>= 1) v += __shfl_xor(v, o);
  return v;
}
DI int crow(int i, int h) { return (i & 3) + 8 * (i >> 2) + 4 * h; }
DI float sigmoidf_(float x) { return 1.f / (1.f + __expf(-x)); }
DI float fexp(float x) { return __builtin_amdgcn_exp2f(x * 1.4426950408889634f); }
DI float frcp(float x) { return __builtin_amdgcn_rcpf(x); }
DI float fsig(float x) { return __builtin_amdgcn_rcpf(1.f + __builtin_amdgcn_exp2f(x * -1.4426950408889634f)); }

DI const float* xsrc(const Params& p, int l, size_t row) {
  if (l == 0) return row < 65536 ? p.in[0] + row * 1024 : p.in[1] + (row - 65536) * 1024;
  return p.out + row * 1024;
}

DI void conv_tile(const float* __restrict__ W, int K, int N, u16* __restrict__ Bt, int ldk, int koff, int kt, int nt, int mode, char* smem, const float* __restrict__ gk = nullptr) {
  float* lds = (float*)smem;
  const int tid = get_tid();
  const int k0 = kt * 64, n0 = nt * 64;
  __syncthreads();
#pragma unroll
  for (int i = 0; i < 8; i++) {
    int kk = (tid >> 6) + 8 * i;
    int n = n0 + (tid & 63);
    const int nc = min(n, N - 1);
    float v = W[(size_t)(k0 + kk) * N + nc];
    v = (n < N) ? v : 0.f;
    const float gv = gk ? gk[k0 + kk] : 1.f;
    lds[kk * 65 + (tid & 63)] = v * gv;
  }
  __syncthreads();
  const int c = tid >> 3, ks = (tid & 7) * 8;
  const int n = n0 + c;
  int drow = n;
  if (mode == 1) {
    int j = n < 2816 ? n : n - 2816;
    drow = (j >> 4) * 32 + (n < 2816 ? 0 : 16) + (j & 15);
  }
  unsigned pk[4];
#pragma unroll
  for (int i = 0; i < 4; i++) pk[i] = pack2(lds[(ks + 2 * i) * 65 + c], lds[(ks + 2 * i + 1) * 65 + c]);
  *(uint4*)(Bt + (size_t)drow * ldk + koff + k0 + ks) = make_uint4(pk[0], pk[1], pk[2], pk[3]);
}

DI void phase_p0(const Params& p, char* smem) {
  const int tid = get_tid();
  u16* wb = (u16*)(p.ws + OFF_WB);
  for (int it = blockIdx.x; it < 2 * 2896 + 128; it += gridDim.x) {
    if (it < 2 * 2896) {
      int l = it / 2896, a = it % 2896;
      u16* wl = wb + (size_t)l * WLAYER;
      if (a < 448) { conv_tile(p.in[3] + (size_t)l * 1024 * 1760, 1024, 1760, wl + WIN, 1024, 0, a % 16, a / 16, 0, smem, p.in[2] + l * 1024); }
      else if (a < 496) { a -= 448; conv_tile(p.in[17] + (size_t)l * 256 * 768, 256, 768, wl + WQKV, 256, 0, a % 4, a / 4, 0, smem, p.in[16] + l * 256); }
      else if (a < 528) { a -= 496; conv_tile(p.in[19] + (size_t)l * 128 * 1024, 128, 1024, wl + WQKV + (size_t)196608, 256, 128, a % 2, a / 2, 0, smem, p.in[18] + l * 128); }
      else if (a < 784) { a -= 528; conv_tile(p.in[27] + (size_t)l * 1024 * 1024, 1024, 1024, wl + WOUT, 1024, 0, a % 16, a / 16, 0, smem); }
      else if (a < 2192) { a -= 784; conv_tile(p.in[29] + (size_t)l * 1024 * 5632, 1024, 5632, wl + WFI, 1024, 0, a % 16, a / 16, 1, smem, p.in[28] + l * 1024); }
      else { a -= 2192; conv_tile(p.in[30] + (size_t)l * 2816 * 1024, 2816, 1024, wl + WFO, 2816, 0, a % 44, a / 44, 0, smem); }
    } else {
      int idx = (it - 2 * 2896) * 512 + tid;
      int s = idx >> 5, i = idx & 31;
      float inv = exp2f(-(float)i * (2.0f / 64.0f) * 13.287712379549449f);
      float ang = (float)s * inv;
      float sn, cs;
      sn = sinf(ang); cs = cosf(ang);
      float2* rope = (float2*)(p.ws + OFF_ROPE);
      rope[idx] = make_float2(cs, sn);
    }
  }
  if (blockIdx.x == 0 && tid < 8) ((int*)(p.ws + OFF_CTR))[tid] = 0;
  if (blockIdx.x == 0) { unsigned* bw = (unsigned*)(p.ws + OFF_BAR); for (int i = tid; i < 3456; i += 512) bw[i] = 0u; }
  {
    float* sq = (float*)(p.ws + OFF_SSQ);
    for (int i = T + blockIdx.x * 512 + tid; i < 8 * T; i += gridDim.x * 512) sq[i] = 0.f;
    for (int i = blockIdx.x * 512 + tid; i < 2 * 16384; i += gridDim.x * 512) {
      const int l = i >> 14, v = i & 16383;
      u16* wkv = wb + (size_t)l * WLAYER + WQKV + 196608;
      *(uint4*)(wkv + (size_t)(v >> 4) * 256 + (v & 15) * 8) = make_uint4(0u, 0u, 0u, 0u);
    }
  }
}

DI void xb_item(const Params& p, int lsrc, u16* __restrict__ xb, float* __restrict__ ssq, int item) {
  const int tid = get_tid(), lane = tid & 63, w = tid >> 6;
#pragma unroll 1
  for (int rr = 0; rr < 16; rr += 4) {
    float4 v[4][4];
#pragma unroll
    for (int j = 0; j < 4; j++) {
      const float* xr = xsrc(p, lsrc, (size_t)item * 128 + w * 16 + rr + j);
#pragma unroll
      for (int i = 0; i < 4; i++) v[j][i] = *(const float4*)(xr + 256 * i + 4 * lane);
    }
#pragma unroll
    for (int j = 0; j < 4; j++) {
      const size_t row = (size_t)item * 128 + w * 16 + rr + j;
      float ss = 0.f;
#pragma unroll
      for (int i = 0; i < 4; i++) ss += v[j][i].x * v[j][i].x + v[j][i].y * v[j][i].y + v[j][i].z * v[j][i].z + v[j][i].w * v[j][i].w;
      ss = wave_sum(ss);
      if (lane == 0) ssq[row] = ss;
#pragma unroll
      for (int i = 0; i < 4; i++) {
        uint2 o;
        o.x = pack2(v[j][i].x, v[j][i].y);
        o.y = pack2(v[j][i].z, v[j][i].w);
        *(uint2*)(xb + row * 1024 + 256 * i + 4 * lane) = o;
      }
    }
  }
}

namespace g8 {
constexpr int BM = 256, BK = 64, HALF = 128, HTB = HALF * BK * 2;
DI int lds_byte(int r, int c) { const int st = (r >> 4) * 2 + (c >> 5), rr = r & 15, cc = c & 31, ob = rr * 64 + cc * 2; return st * 1024 + (ob ^ (((ob >> 9) & 1) << 5)); }
DI void stage_rc(int b, int& R, int& C) { const int st = b / 1024, sb = b % 1024, swz = sb ^ (((sb >> 9) & 1) << 5); R = (st >> 1) * 16 + swz / 64; C = (st & 1) * 32 + (swz % 64) / 2; }
DI int perm32(int rho) { const int n = rho >> 4, i = rho & 15; return 8 * (i >> 2) + 4 * n + (i & 3); }
struct Unit { int pm, pn; };
struct Order {
  int NT, C;
  int R = 48, roff = 0;
  DI bool next(int k, Unit& u) const {
    const int g = blockIdx.x & 7, j = blockIdx.x >> 3, J = gridDim.x >> 3;
    const int q = k * J + j;
    if (q >= R * NT) return false;
    const int P = R * C;
    const int pc = q / P, rem = q - pc * P;
    const int cw = min(C, NT - pc * C);
    const int mtl = rem / cw, nc = rem - mtl * cw;
    u.pm = 48 * g + roff + mtl;
    u.pn = pc * C + nc;
    return true;
  }
};

template <class Epi>
DI void gemm_phase(LAS unsigned char* lds, const u16* __restrict__ Aptr, int lda, const u16* __restrict__ Btptr, int K, const Order& S, const Epi& E) {
  const int tid = get_tid(), wid = __builtin_amdgcn_readfirstlane(tid >> 6), lane = tid & 63, wr = wid >> 2, wc = wid & 3, fr = lane & 15, fq = lane >> 4;
  const int nt = K / BK;
  unsigned voffA[2], voffB[2];
#pragma unroll
  for (int i = 0; i < 2; ++i) {
    int R, C;
    stage_rc(tid * 16 + i * 8192, R, C);
    const int Rb = Epi::PERM ? ((R & ~31) + perm32(R & 31)) : R;
    voffA[i] = (unsigned)(R * lda + C) * 2u;
    voffB[i] = (unsigned)(Rb * K + C) * 2u;
  }
  const size_t kstep = (size_t)(BK * 2);
  const size_t hstepA = (size_t)HALF * lda * 2, hstepB = (size_t)HALF * K * 2;
  const size_t tstepA = 2 * hstepA, tstepB = 2 * hstepB;
  const unsigned ldsw = (unsigned)wid * 1024u;
  const int aoff = lds_byte(wr * 64 + fr, fq * 8), boff = lds_byte(wc * 32 + fr, fq * 8);
#define G8_SA(b, h) (((b) * 2 + (h)) * HTB)
#define G8_SB(b, h) ((4 + (b) * 2 + (h)) * HTB)
#define G8_STAGE(bufoff, gbase, voff) do { _Pragma("unroll") for (int _i = 0; _i < 2; ++_i) \
    __builtin_amdgcn_global_load_lds((const unsigned*)((const char*)(gbase) + (voff)[_i]), (LAS unsigned*)(lds + (bufoff) + ldsw + _i * 8192), 16, 0, 0); } while (0)
#define G8_LDA(dst, b, h) do { _Pragma("unroll") for (int m = 0; m < 4; ++m) _Pragma("unroll") for (int k = 0; k < 2; ++k) dst[m][k] = *(const LAS bf16x8*)(lds + G8_SA(b, h) + aoff + m * 2048 + k * 1024); } while (0)
#define G8_LDB(dst, b, h) do { _Pragma("unroll") for (int n = 0; n < 2; ++n) _Pragma("unroll") for (int k = 0; k < 2; ++k) dst[n][k] = *(const LAS bf16x8*)(lds + G8_SB(b, h) + boff + n * 2048 + k * 1024); } while (0)
#define G8_MMA(ai, bj, At, Bt) do { __builtin_amdgcn_s_setprio(1); _Pragma("unroll") for (int m = 0; m < 4; ++m) _Pragma("unroll") for (int n = 0; n < 2; ++n) _Pragma("unroll") for (int k = 0; k < 2; ++k) \
    acc[ai][bj][m][n] = __builtin_amdgcn_mfma_f32_16x16x32_bf16(Bt[n][k], At[m][k], acc[ai][bj][m][n], 0, 0, 0); __builtin_amdgcn_s_setprio(0); } while (0)
#define G8_WAIT_V(n) asm volatile("s_waitcnt vmcnt(" #n ")" ::: "memory")
#define G8_WAIT_L(n) asm volatile("s_waitcnt lgkmcnt(" #n ")" ::: "memory")
#define G8_BAR __builtin_amdgcn_s_barrier()
#define G8_SCHED __builtin_amdgcn_sched_barrier(0)
  Unit cur, nxt;
  int ui = 0;
  if (!S.next(0, cur)) return;
  f32x4v acc[2][2][4][2];
#pragma unroll
  for (int a = 0; a < 2; ++a)
#pragma unroll
    for (int b = 0; b < 2; ++b)
#pragma unroll
      for (int m = 0; m < 4; ++m)
#pragma unroll
        for (int n = 0; n < 2; ++n) acc[a][b][m][n] = (f32x4v){0.f, 0.f, 0.f, 0.f};
  bf16x8 At[4][2], B0[2][2], B1[2][2];
  const char* cA = (const char*)Aptr + (size_t)cur.pm * tstepA;
  const char* cB = (const char*)Btptr + (size_t)cur.pn * tstepB;
  G8_STAGE(G8_SB(0, 0), cB, voffB); G8_STAGE(G8_SA(0, 0), cA, voffA); G8_STAGE(G8_SB(0, 1), cB + hstepB, voffB); G8_STAGE(G8_SA(0, 1), cA + hstepA, voffA);
  if (wr == 1) G8_BAR;
  G8_WAIT_V(4); G8_BAR;
  G8_STAGE(G8_SB(1, 0), cB + kstep, voffB); G8_STAGE(G8_SA(1, 0), cA + kstep, voffA); G8_STAGE(G8_SB(1, 1), cB + hstepB + kstep, voffB);
  G8_WAIT_V(6); G8_BAR;
  for (;;) {
    const bool has_next = S.next(ui + 1, nxt);
    const char* nA = has_next ? (const char*)Aptr + (size_t)nxt.pm * tstepA : cA;
    const char* nB = has_next ? (const char*)Btptr + (size_t)nxt.pn * tstepB : cB;
    for (int t = 0; t < nt; t += 2) {
      const bool last = (t == nt - 2);
      const char* a1 = cA + (size_t)(t + 1) * kstep;
      const char* a2 = last ? nA : cA + (size_t)(t + 2) * kstep;
      const char* b2 = last ? nB : cB + (size_t)(t + 2) * kstep;
      const char* a3 = a2 + kstep;
      const char* b3 = b2 + kstep;
      G8_LDB(B0, 0, 0); G8_SCHED; G8_LDA(At, 0, 0); G8_STAGE(G8_SA(1, 1), a1 + hstepA, voffA);
      G8_WAIT_L(8); G8_BAR; G8_WAIT_L(0); G8_MMA(0, 0, At, B0); G8_BAR; G8_SCHED;
      G8_LDB(B1, 0, 1); G8_STAGE(G8_SB(0, 0), b2, voffB);
      G8_BAR; G8_WAIT_L(0); G8_MMA(0, 1, At, B1); G8_BAR;
      G8_LDA(At, 0, 1); G8_STAGE(G8_SA(0, 0), a2, voffA);
      G8_BAR; G8_WAIT_L(0); G8_MMA(1, 0, At, B0); G8_BAR; G8_SCHED;
      G8_STAGE(G8_SB(0, 1), b2 + hstepB, voffB);
      G8_WAIT_V(6); G8_BAR; G8_MMA(1, 1, At, B1); G8_BAR;
      G8_LDB(B0, 1, 0); G8_SCHED; G8_LDA(At, 1, 0); G8_STAGE(G8_SA(0, 1), a2 + hstepA, voffA);
      G8_WAIT_L(8); G8_BAR; G8_WAIT_L(0); G8_MMA(0, 0, At, B0); G8_BAR; G8_SCHED;
      G8_LDB(B1, 1, 1); G8_STAGE(G8_SB(1, 0), b3, voffB);
      G8_BAR; G8_WAIT_L(0); G8_MMA(0, 1, At, B1); G8_BAR;
      G8_LDA(At, 1, 1); G8_STAGE(G8_SA(1, 0), a3, voffA);
      G8_BAR; G8_WAIT_L(0); G8_MMA(1, 0, At, B0); G8_BAR; G8_SCHED;
      G8_STAGE(G8_SB(1, 1), b3 + hstepB, voffB);
      G8_WAIT_V(6); G8_BAR; G8_MMA(1, 1, At, B1); G8_BAR;
    }
    E(acc, cur, wr, wc, fr, fq);
    if (!has_next) break;
#pragma unroll
    for (int a = 0; a < 2; ++a)
#pragma unroll
      for (int b = 0; b < 2; ++b)
#pragma unroll
        for (int m = 0; m < 4; ++m)
#pragma unroll
          for (int n = 0; n < 2; ++n) acc[a][b][m][n] = (f32x4v){0.f, 0.f, 0.f, 0.f};
    cur = nxt; cA = nA; cB = nB; ++ui;
  }
  G8_WAIT_V(0);
  if (wr == 0) G8_BAR;
  G8_BAR;
#undef G8_SA
#undef G8_SB
#undef G8_STAGE
#undef G8_LDA
#undef G8_LDB
#undef G8_MMA
#undef G8_WAIT_V
#undef G8_WAIT_L
#undef G8_BAR
#undef G8_SCHED
}

struct EpiBf16 {
  static constexpr bool PERM = true;
  u16* c0; int ldc0; int split_pn; u16* c1; int ldc1; int nvalid;
  const float* ssq0; float inv0; const float* ssq1; float inv1;
  float* sq_a; float* sq_b;
  DI void operator()(const f32x4v (&acc)[2][2][4][2], const Unit& u, int wr, int wc, int fr, int fq) const {
    const int row0 = u.pm * BM + wr * 64 + fr;
    u16* base = c0; int ldc = ldc0; int colt = u.pn * BM;
    const float* ssq = ssq0; float inv = inv0;
    if (u.pn >= split_pn) { base = c1; ldc = ldc1; colt -= split_pn * BM; ssq = ssq1; inv = inv1; }
    const int col0 = colt + wc * 32 + 8 * fq;
    float* sqo = nullptr; int nbj = 0;
    if (sq_a) { if (u.pn == 2) { sqo = sq_a; nbj = 2; } else if (u.pn == 3) { sqo = sq_b; nbj = 1; } }
    float rsv[2][4];
#pragma unroll
    for (int ai = 0; ai < 2; ++ai)
#pragma unroll
      for (int m = 0; m < 4; ++m) rsv[ai][m] = ssq ? ssq[row0 + ai * HALF + m * 16] : 0.f;
#pragma unroll
    for (int ai = 0; ai < 2; ++ai)
#pragma unroll
      for (int m = 0; m < 4; ++m) rsv[ai][m] = ssq ? rsqrtf(rsv[ai][m] * inv + EPS) : 1.f;
    float ssv[2][4];
#pragma unroll
    for (int ai = 0; ai < 2; ++ai)
#pragma unroll
      for (int m = 0; m < 4; ++m) {
        const int row = row0 + ai * HALF + m * 16;
        const float rs = rsv[ai][m];
        u16* rowp = base + (size_t)row * ldc + col0;
        float ss = 0.f;
#pragma unroll
        for (int bj = 0; bj < 2; ++bj) {
          if (col0 + bj * HALF < nvalid) {
            const f32x4v v0 = acc[ai][bj][m][0] * rs, v1 = acc[ai][bj][m][1] * rs;
            u32x4 w4 = {pack2(v0[0], v0[1]), pack2(v0[2], v0[3]), pack2(v1[0], v1[1]), pack2(v1[2], v1[3])};
            *(u32x4*)(rowp + bj * HALF) = w4;
            if (bj < nbj) ss += v0[0] * v0[0] + v0[1] * v0[1] + v0[2] * v0[2] + v0[3] * v0[3] + v1[0] * v1[0] + v1[1] * v1[1] + v1[2] * v1[2] + v1[3] * v1[3];
          }
        }
        ssv[ai][m] = ss;
      }
    if (sqo) {
#pragma unroll
      for (int ai = 0; ai < 2; ++ai)
#pragma unroll
        for (int m = 0; m < 4; ++m) {
          float ss = ssv[ai][m];
          ss += __shfl_xor(ss, 16);
          ss += __shfl_xor(ss, 32);
          if (fq == 0) atomicAdd(sqo + row0 + ai * HALF + m * 16, ss);
        }
    }
  }
};
struct EpiSwiglu {
  static constexpr bool PERM = false;
  u16* hid; const float* ssq;
  DI void operator()(const f32x4v (&acc)[2][2][4][2], const Unit& u, int wr, int wc, int fr, int fq) const {
    const int row0 = u.pm * BM + wr * 64 + fr;
    const int col0 = (u.pn * BM + wc * 32) / 2 + 4 * fq;
    float rsv[2][4];
#pragma unroll
    for (int ai = 0; ai < 2; ++ai)
#pragma unroll
      for (int m = 0; m < 4; ++m) rsv[ai][m] = ssq[row0 + ai * HALF + m * 16];
#pragma unroll
    for (int ai = 0; ai < 2; ++ai)
#pragma unroll
      for (int m = 0; m < 4; ++m) {
        const int row = row0 + ai * HALF + m * 16;
        const float rs = rsqrtf(rsv[ai][m] * (1.f / 1024.f) + EPS);
        u16* rowp = hid + (size_t)row * 2816 + col0;
#pragma unroll
        for (int bj = 0; bj < 2; ++bj) {
          float v[4];
#pragma unroll
          for (int q = 0; q < 4; q++) {
            const float gt = acc[ai][bj][m][0][q] * rs, up = acc[ai][bj][m][1][q] * rs;
            v[q] = gt * fsig(gt) * up;
          }
          uint2 o;
          o.x = pack2(v[0], v[1]);
          o.y = pack2(v[2], v[3]);
          *(uint2*)(rowp + bj * 64) = o;
        }
      }
  }
};
struct EpiRes {
  static constexpr bool PERM = false;
  const float* xin0; const float* xin1; float* xout; u16* xb; float* ssq_out;
  DI void operator()(const f32x4v (&acc)[2][2][4][2], const Unit& u, int wr, int wc, int fr, int fq) const {
    const int row0 = u.pm * BM + wr * 64 + fr;
    const int col0 = u.pn * BM + wc * 32 + 4 * fq;
    const float* xin = (row0 < 65536) ? xin0 : xin1;
#pragma unroll
    for (int ai = 0; ai < 2; ++ai) {
      f32x4v xi[4][2][2];
#pragma unroll
      for (int m = 0; m < 4; ++m)
#pragma unroll
        for (int bj = 0; bj < 2; ++bj)
#pragma unroll
          for (int n = 0; n < 2; ++n)
            xi[m][bj][n] = *(const f32x4v*)(xin + (size_t)(row0 + ai * HALF + m * 16) * 1024 + col0 + bj * HALF + n * 16);
      float ssr[4];
#pragma unroll
      for (int m = 0; m < 4; ++m) {
        const size_t row = (size_t)(row0 + ai * HALF + m * 16);
        float ss = 0.f;
#pragma unroll
        for (int bj = 0; bj < 2; ++bj)
#pragma unroll
          for (int n = 0; n < 2; ++n) {
            const int col = col0 + bj * HALF + n * 16;
            const f32x4v xo = xi[m][bj][n] + acc[ai][bj][m][n];
            *(f32x4v*)(xout + row * 1024 + col) = xo;
            if (xb) {
              uint2 o;
              o.x = pack2(xo[0], xo[1]);
              o.y = pack2(xo[2], xo[3]);
              *(uint2*)(xb + row * 1024 + col) = o;
              ss += xo[0] * xo[0] + xo[1] * xo[1] + xo[2] * xo[2] + xo[3] * xo[3];
            }
          }
        ssr[m] = ss;
      }
      if (xb) {
#pragma unroll
        for (int m = 0; m < 4; ++m) {
          float ss = ssr[m];
          ss += __shfl_xor(ss, 16);
          ss += __shfl_xor(ss, 32);
          if (fq == 0) atomicAdd(ssq_out + (size_t)(row0 + ai * HALF + m * 16), ss);
        }
      }
    }
  }
};
}

DI void latent_item(const Params& p, int l, u16* __restrict__ z, int item) {
  const int tid = get_tid(), lane = tid & 63, w = tid >> 6;
  const float* gcq = p.in[16] + l * 256;
  const float* gckv = p.in[18] + l * 128;
  float4 g1 = *(const float4*)(gcq + 4 * lane);
  float2 g2 = *(const float2*)(gckv + 2 * lane);
  for (int rr = 0; rr < 16; rr++) {
    size_t t = (size_t)item * 128 + w * 16 + rr;
    u16* zr = z + t * 1760;
    uint2 a = *(const uint2*)(zr + 512 + 4 * lane);
    unsigned b = *(const unsigned*)(zr + 768 + 2 * lane);
    float a0 = bflo(a.x), a1 = bfhi(a.x), a2 = bflo(a.y), a3 = bfhi(a.y);
    float b0 = bflo(b), b1 = bfhi(b);
    float s1 = wave_sum(a0 * a0 + a1 * a1 + a2 * a2 + a3 * a3);
    float s2 = wave_sum(b0 * b0 + b1 * b1);
    float r1 = rsqrtf(s1 * (1.f / 256.f) + EPS), r2 = rsqrtf(s2 * (1.f / 128.f) + EPS);
    uint2 o;
    o.x = pack2(a0 * r1 * g1.x, a1 * r1 * g1.y);
    o.y = pack2(a2 * r1 * g1.z, a3 * r1 * g1.w);
    *(uint2*)(zr + 512 + 4 * lane) = o;
    *(unsigned*)(zr + 768 + 2 * lane) = pack2(b0 * r2 * g2.x, b1 * r2 * g2.y);
  }
}

DI void prep_item(const Params& p, int l, int item) {
  const int tid = get_tid(), lane = tid & 63, w = tid >> 6;
  u16* qb = (u16*)(p.ws + OFF_Q);
  u16* kb = (u16*)(p.ws + OFF_K);
  u16* vt = (u16*)(p.ws + OFF_VT);
  const u16* kvraw = (const u16*)(p.ws + OFF_H);
  const u16* z = (const u16*)(p.ws + OFF_Z);
  const float2* rope = (const float2*)(p.ws + OFF_ROPE);
  const float* gq = p.in[20] + l * 192;
  const float* gk = p.in[21] + l * 192;
  const float gq0 = gq[lane], gq1 = gq[64 + lane], gq2 = gq[128 + lane];
  const float gk0 = gk[lane], gk1 = gk[64 + lane], gk2 = gk[128 + lane];
  const float QS = 0.07216878364870322f * 1.4426950408889634f;
  const size_t tb = (size_t)item * 128 + w * 16;
  const int seq = (int)(tb >> 11), s0 = (int)(tb & 2047);
#pragma unroll 1
  for (int hd = 0; hd < 4; hd++) {
    unsigned vv[16];
#pragma unroll
    for (int t4 = 0; t4 < 16; t4 += 4) {
      u16 qa[4][3], ka[4][3];
      float2 csa[4];
#pragma unroll
      for (int j = 0; j < 4; j++) {
        const size_t t = tb + t4 + j;
        csa[j] = rope[(s0 + t4 + j) * 32 + (lane & 31)];
        const u16* qr = qb + t * 768 + hd * 192;
        qa[j][0] = qr[lane]; qa[j][1] = qr[64 + lane]; qa[j][2] = qr[128 + lane];
        const u16* kvr = kvraw + t * 1024 + hd * 256;
        ka[j][0] = kvr[lane]; ka[j][1] = kvr[64 + lane]; ka[j][2] = z[t * 1760 + 896 + lane];
        vv[t4 + j] = *(const unsigned*)(kvr + 128 + 2 * lane);
      }
#pragma unroll
      for (int j = 0; j < 4; j++) {
        const size_t t = tb + t4 + j;
        const float2 cs = csa[j];
        u16* qr = qb + t * 768 + hd * 192;
        float q0 = bf2f(qa[j][0]), q1 = bf2f(qa[j][1]), q2 = bf2f(qa[j][2]);
        float ss = wave_sum(q0 * q0 + q1 * q1 + q2 * q2);
        float rs = rsqrtf(ss * (1.f / 192.f) + EPS);
        q0 *= rs * gq0; q1 *= rs * gq1; q2 *= rs * gq2;
        float pr = __shfl_xor(q2, 32);
        float rot = (lane < 32) ? (q2 * cs.x - pr * cs.y) : (q2 * cs.x + pr * cs.y);
        qr[lane] = f2bf(q0 * QS); qr[64 + lane] = f2bf(q1 * QS); qr[128 + lane] = f2bf(rot * QS);
        float k0 = bf2f(ka[j][0]), k1 = bf2f(ka[j][1]), k2 = bf2f(ka[j][2]);
        float ks = wave_sum(k0 * k0 + k1 * k1 + k2 * k2);
        float rk = rsqrtf(ks * (1.f / 192.f) + EPS);
        k0 *= rk * gk0; k1 *= rk * gk1; k2 *= rk * gk2;
        float pk = __shfl_xor(k2, 32);
        float rotk = (lane < 32) ? (k2 * cs.x - pk * cs.y) : (k2 * cs.x + pk * cs.y);
        u16* kr = kb + t * 768 + hd * 192;
        kr[lane] = f2bf(k0); kr[64 + lane] = f2bf(k1); kr[128 + lane] = f2bf(rotk);
      }
    }
#pragma unroll
    for (int e2 = 0; e2 < 2; e2++) {
      unsigned o[8];
#pragma unroll
      for (int pp = 0; pp < 8; pp++) {
        const int p0 = 2 * pp, p1 = 2 * pp + 1;
        const int o0 = ((p0 >> 2) & 1) * 8 + (p0 >> 3) * 4 + (p0 & 3);
        const int o1 = ((p1 >> 2) & 1) * 8 + (p1 >> 3) * 4 + (p1 & 3);
        unsigned lo = e2 ? (vv[o0] >> 16) : (vv[o0] & 0xffffu);
        unsigned hi = e2 ? (vv[o1] >> 16) : (vv[o1] & 0xffffu);
        o[pp] = lo | (hi << 16);
      }
      uint4* dst = (uint4*)(vt + ((size_t)(seq * 4 + hd) * 128 + 2 * lane + e2) * 2048 + s0);
      dst[0] = make_uint4(o[0], o[1], o[2], o[3]);
      dst[1] = make_uint4(o[4], o[5], o[6], o[7]);
    }
  }
}

DI void attn_item(const Params& p, int seq, int hd, int qblk, char* smem, int tid_) {
  const u16* qb = (const u16*)(p.ws + OFF_Q);
  const u16* kb = (const u16*)(p.ws + OFF_K);
  const u16* vt = (const u16*)(p.ws + OFF_VT);
  u16* mixed = (u16*)(p.ws + OFF_H);
  int tid = tid_;
  asm volatile("" : "+v"(tid));
  const int lane = tid & 63, w = tid >> 6, r = lane & 31, h = lane >> 5;
  const size_t qrow = (size_t)seq * 2048 + qblk * 256 + w * 32 + r;
  bf16x8 qf[12];
#pragma unroll
  for (int s = 0; s < 12; s++) qf[s] = *(const bf16x8*)(qb + qrow * 768 + hd * 192 + 16 * s + 8 * h);
  f32x16 o[4];
#pragma unroll
  for (int db = 0; db < 4; db++)
#pragma unroll
    for (int i = 0; i < 16; i++) o[db][i] = 0.f;
  float m = -1e30f, lsum = 0.f;
  const u16* kg = kb + ((size_t)seq * 2048 + (tid >> 3)) * 768 + hd * 192 + (tid & 7) * 8;
  const int kl = (tid >> 3) * 200 + (tid & 7) * 8;
  const u16* vg = vt + ((size_t)(seq * 4 + hd) * 128 + (tid >> 3)) * 2048 + (tid & 7) * 8;
  const int vl = (tid >> 3) * 72 + (tid & 7) * 8;
  u32x4 rk[3], rv[2];
#pragma unroll
  for (int i = 0; i < 3; i++) rk[i] = *(const u32x4*)(kg + 64 * i);
#pragma unroll
  for (int i = 0; i < 2; i++) rv[i] = *(const u32x4*)(vg + (size_t)(64 * i) * 2048);
  __syncthreads();
  {
    u16* sK0 = (u16*)smem;
    u16* sV0 = sK0 + 64 * 200;
#pragma unroll
    for (int i = 0; i < 3; i++) *(u32x4*)(sK0 + kl + 64 * i) = rk[i];
#pragma unroll
    for (int i = 0; i < 2; i++) *(u32x4*)(sV0 + vl + 64 * i * 72) = rv[i];
  }
  __syncthreads();
#pragma unroll
  for (int i = 0; i < 3; i++) rk[i] = *(const u32x4*)(kg + (size_t)64 * 768 + 64 * i);
#pragma unroll
  for (int i = 0; i < 2; i++) rv[i] = *(const u32x4*)(vg + (size_t)(64 * i) * 2048 + 64);
  for (int kt = 0; kt < 32; kt++) {
    const u16* sK = (const u16*)(smem + (kt & 1) * 45056);
    const u16* sV = sK + 64 * 200;
    f32x16 st[2];
#pragma unroll
    for (int kb2 = 0; kb2 < 2; kb2++)
#pragma unroll
      for (int i = 0; i < 16; i++) st[kb2][i] = 0.f;
#define KFRAG(F) (*(const bf16x8*)(sK + ((((F) / 12) * 32 + r) * 200 + 16 * ((F) % 12) + 8 * h)))
#define VFRAG(G) (*(const bf16x8*)(sV + ((32 * ((G) & 3) + r) * 72 + ((G) >> 2) * 16 + 8 * h)))
    {
      bf16x8 kfr[4];
#pragma unroll
      for (int f = 0; f < 4; f++) kfr[f] = KFRAG(f);
      __builtin_amdgcn_sched_barrier(0);
#pragma unroll
      for (int f = 0; f < 24; f++) {
        st[f / 12] = MFMA(kfr[f & 3], qf[f % 12], st[f / 12]);
        if (f + 4 < 24) kfr[f & 3] = KFRAG(f + 4);
        __builtin_amdgcn_sched_barrier(0);
      }
    }
    bf16x8 vfr[4];
#pragma unroll
    for (int g = 0; g < 4; g++) vfr[g] = VFRAG(g);
    float mx = st[0][0];
#pragma unroll
    for (int i = 1; i < 16; i++) mx = fmaxf(mx, st[0][i]);
#pragma unroll
    for (int i = 0; i < 16; i++) mx = fmaxf(mx, st[1][i]);
    mx = fmaxf(mx, __shfl_xor(mx, 32));
    if (__any((fmaxf(m, mx) - m) > 8.f)) {
      const float mnew = fmaxf(m, mx);
      const float alpha = __builtin_amdgcn_exp2f(m - mnew);
      m = mnew;
      lsum *= alpha;
#pragma unroll
      for (int db = 0; db < 4; db++)
#pragma unroll
        for (int i = 0; i < 16; i++) o[db][i] *= alpha;
    }
    float ps = 0.f;
#pragma unroll
    for (int kb2 = 0; kb2 < 2; kb2++)
#pragma unroll
      for (int i = 0; i < 16; i++) {
        float pv = __builtin_amdgcn_exp2f(st[kb2][i] - m);
        st[kb2][i] = pv;
        ps += pv;
      }
    lsum += ps;
    __builtin_amdgcn_sched_barrier(0);
#pragma unroll
    for (int g = 0; g < 16; g++) {
      const int kb2 = g >> 3, c = (g >> 2) & 1;
      unsigned pk[4];
#pragma unroll
      for (int j = 0; j < 4; j++) pk[j] = pack2(st[kb2][8 * c + 2 * j], st[kb2][8 * c + 2 * j + 1]);
      u32x4 pu = {pk[0], pk[1], pk[2], pk[3]};
      bf16x8 pf = __builtin_bit_cast(bf16x8, pu);
      o[g & 3] = MFMA(vfr[g & 3], pf, o[g & 3]);
      if (g + 4 < 16) vfr[g & 3] = VFRAG(g + 4);
      __builtin_amdgcn_sched_barrier(0);
    }
#undef KFRAG
#undef VFRAG
    if (kt + 1 < 32) {
      u16* sKn = (u16*)(smem + ((kt + 1) & 1) * 45056);
      u16* sVn = sKn + 64 * 200;
#pragma unroll
      for (int i = 0; i < 3; i++) *(u32x4*)(sKn + kl + 64 * i) = rk[i];
#pragma unroll
      for (int i = 0; i < 2; i++) *(u32x4*)(sVn + vl + 64 * i * 72) = rv[i];
    }
    __syncthreads();
    if (kt + 2 < 32) {
#pragma unroll
      for (int i = 0; i < 3; i++) rk[i] = *(const u32x4*)(kg + (size_t)(kt + 2) * 64 * 768 + 64 * i);
#pragma unroll
      for (int i = 0; i < 2; i++) rv[i] = *(const u32x4*)(vg + (size_t)(64 * i) * 2048 + (kt + 2) * 64);
    }
  }
  lsum += __shfl_xor(lsum, 32);
  const float inv = 1.f / lsum;
  u16* orow = mixed + qrow * 1024 + 256 + hd * 128;
#pragma unroll
  for (int db = 0; db < 4; db++)
#pragma unroll
    for (int g = 0; g < 4; g++) {
      uint2 ov;
      ov.x = pack2(o[db][4 * g] * inv, o[db][4 * g + 1] * inv);
      ov.y = pack2(o[db][4 * g + 2] * inv, o[db][4 * g + 3] * inv);
      *(uint2*)(orow + 32 * db + 8 * g + 4 * h) = ov;
    }
}

DI float gelu_tanh(float x) {
  float y = 0.7978845608028654f * (x + 0.044715f * x * x * x);
  float e = __builtin_amdgcn_exp2f(y * 2.8853900817779268f);
  float th = 1.f - 2.f * __builtin_amdgcn_rcpf(e + 1.f);
  return 0.5f * x * (1.f + th);
}
DI constexpr int perm16(int o) { return ((o >> 2) & 1) * 8 + (o >> 3) * 4 + (o & 3); }
DI constexpr int invperm16(int q) { return ((q & 7) >> 2) * 8 + (q >> 3) * 4 + (q & 3); }
DI bf16x8 pack8(float a0, float a1, float a2, float a3, float a4, float a5, float a6, float a7) {
  u32x4 u = {pack2(a0, a1), pack2(a2, a3), pack2(a4, a5), pack2(a6, a7)};
  return __builtin_bit_cast(bf16x8, u);
}
#define PACK8(v, s) pack8(v[8 * (s)], v[8 * (s) + 1], v[8 * (s) + 2], v[8 * (s) + 3], v[8 * (s) + 4], v[8 * (s) + 5], v[8 * (s) + 6], v[8 * (s) + 7])

template <int DIR>
DI void lru_dir(const Params& p, int l, int n, int r_, int h_, u16* __restrict__ zb, u16* __restrict__ mb, u16* uL,
                float cw0, float cw1, float cw2, float cw3, float cb) {
  int r = r_, h = h_;
  const int ch = n * 32 + r;
  const float* Wa = p.in[DIR ? 11 : 6] + (size_t)l * 8192 + n * 1024 + r;
  const float* Wx = p.in[DIR ? 13 : 8] + (size_t)l * 8192 + n * 1024 + r;
  bf16x8 bwa[2], bwx[2];
#pragma unroll
  for (int s = 0; s < 2; s++) {
    float a[8], x[8];
#pragma unroll
    for (int j = 0; j < 8; j++) { a[j] = Wa[(16 * s + 8 * h + j) * 32]; x[j] = Wx[(16 * s + 8 * h + j) * 32]; }
    bwa[s] = PACK8(a, 0);
    bwx[s] = PACK8(x, 0);
  }
  const float ba = p.in[DIR ? 12 : 7][l * 256 + ch];
  const float bx = p.in[DIR ? 14 : 9][l * 256 + ch];
  const float lam = p.in[DIR ? 15 : 10][l * 256 + ch];
  const float sp8 = -8.f * (fmaxf(-lam, 0.f) + log1pf(__expf(-fabsf(lam))));
  const float sp8l2 = sp8 * 1.4426950408889634f;
  float Hc = 0.f;
  f32x16 zero;
#pragma unroll
  for (int i = 0; i < 16; i++) zero[i] = 0.f;
  u16 xr[28];
  {
    const int tb0 = (DIR ? 63 : 0) * 32;
#pragma unroll
    for (int g = 0; g < 4; g++)
#pragma unroll
      for (int m = 0; m < 7; m++) {
        const int tt = tb0 + 8 * g + 4 * h - 2 + m;
        const int tc = min(max(tt, 0), 2047);
        xr[7 * g + m] = zb[(unsigned)tc * 1760u + (unsigned)(n * 32 + r)];
      }
  }
#pragma unroll 1
  for (int tl = 0; tl < 64; tl++) {
    const int tile = DIR ? 63 - tl : tl;
    const int tb = tile * 32;
    asm volatile("" : "+v"(r), "+v"(h));
    const unsigned chz = n * 32 + r;
    u16 xn[28];
    {
      const int tln = (tl + 1 < 64) ? tl + 1 : tl;
      const int tbn = (DIR ? 63 - tln : tln) * 32;
#pragma unroll
      for (int g = 0; g < 4; g++)
#pragma unroll
        for (int m = 0; m < 7; m++) {
          const int tt = tbn + 8 * g + 4 * h - 2 + m;
          const int tc = min(max(tt, 0), 2047);
          xn[7 * g + m] = zb[(unsigned)tc * 1760u + chz];
        }
    }
    float uv[16];
#pragma unroll
    for (int g = 0; g < 4; g++) {
      const int t0 = tb + 8 * g + 4 * h;
      float x[7];
#pragma unroll
      for (int m = 0; m < 7; m++) {
        const int tt = t0 - 2 + m;
        x[m] = (tt >= 0 && tt < 2048) ? bf2f(xr[7 * g + m]) : 0.f;
      }
#pragma unroll
      for (int e = 0; e < 4; e++) uv[4 * g + e] = cb + cw0 * x[e] + cw1 * x[e + 1] + cw2 * x[e + 2] + cw3 * x[e + 3];
    }
    __builtin_amdgcn_wave_barrier();
#pragma unroll
    for (int i = 0; i < 16; i++) uL[crow(i, h) * 40 + r] = f2bf(uv[i]);
    __builtin_amdgcn_wave_barrier();
    bf16x8 a0 = *(const bf16x8*)(uL + r * 40 + 8 * h);
    bf16x8 a1 = *(const bf16x8*)(uL + r * 40 + 16 + 8 * h);
    f32x16 rp = MFMA(a0, bwa[0], zero);
    rp = MFMA(a1, bwa[1], rp);
    f32x16 ip = MFMA(a0, bwx[0], zero);
    ip = MFMA(a1, bwx[1], ip);
    float av[16], uu[16];
#pragma unroll
    for (int i = 0; i < 16; i++) {
      const float rg = fsig(rp[i] + ba), ig = fsig(ip[i] + bx);
      const float a = __builtin_amdgcn_exp2f(sp8l2 * rg);
      av[i] = a;
      uu[i] = __builtin_amdgcn_sqrtf(fmaxf(1.f - a * a, 0.f)) * ig * uv[i];
    }
    float gA[4], gB[4];
#pragma unroll
    for (int g = 0; g < 4; g++) {
      if (DIR == 0) {
        gA[g] = av[4 * g] * av[4 * g + 1] * av[4 * g + 2] * av[4 * g + 3];
        gB[g] = ((uu[4 * g] * av[4 * g + 1] + uu[4 * g + 1]) * av[4 * g + 2] + uu[4 * g + 2]) * av[4 * g + 3] + uu[4 * g + 3];
      } else {
        gA[g] = av[4 * g] * av[4 * g + 1] * av[4 * g + 2] * av[4 * g + 3];
        gB[g] = uu[4 * g] + av[4 * g] * (uu[4 * g + 1] + av[4 * g + 1] * (uu[4 * g + 2] + av[4 * g + 2] * uu[4 * g + 3]));
      }
    }
    float pA[4], pB[4];
#pragma unroll
    for (int g = 0; g < 4; g++) { pA[g] = __shfl_xor(gA[g], 32); pB[g] = __shfl_xor(gB[g], 32); }
    float myin[4];
    float sst = Hc;
    if (DIR == 0) {
#pragma unroll
      for (int g = 0; g < 4; g++) {
        const float eA = h ? pA[g] : gA[g], eB = h ? pB[g] : gB[g];
        const float oA = h ? gA[g] : pA[g], oB = h ? gB[g] : pB[g];
        const float ine = sst;
        sst = eA * sst + eB;
        const float ino = sst;
        sst = oA * sst + oB;
        myin[g] = h ? ino : ine;
      }
    } else {
#pragma unroll
      for (int g = 3; g >= 0; g--) {
        const float eA = h ? pA[g] : gA[g], eB = h ? pB[g] : gB[g];
        const float oA = h ? gA[g] : pA[g], oB = h ? gB[g] : pB[g];
        const float ino = sst;
        sst = oA * sst + oB;
        const float ine = sst;
        sst = eA * sst + eB;
        myin[g] = h ? ino : ine;
      }
    }
    Hc = sst;
    float hv[16];
#pragma unroll
    for (int g = 0; g < 4; g++) {
      float hc = myin[g];
      if (DIR == 0) {
#pragma unroll
        for (int e = 0; e < 4; e++) { hc = av[4 * g + e] * hc + uu[4 * g + e]; hv[4 * g + e] = hc; }
      } else {
#pragma unroll
        for (int e = 3; e >= 0; e--) { hc = av[4 * g + e] * hc + uu[4 * g + e]; hv[4 * g + e] = hc; }
      }
    }
#pragma unroll
    for (int i = 0; i < 16; i++) {
      const int tt = tb + crow(i, h);
      if (DIR == 0) mb[(unsigned)tt * 1024u + chz] = f2bf(hv[i]);
      else zb[(unsigned)tt * 1760u + 512u + chz] = f2bf(hv[i]);
    }
#pragma unroll
    for (int i = 0; i < 28; i++) xr[i] = xn[i];
  }
}

DI void lru_wave(const Params& p, int l, int seq, int n, int dir, char* lw, int lane_) {
  int lane = lane_;
  asm volatile("" : "+v"(lane));
  const int r = lane & 31, h = lane >> 5;
  const int ch = n * 32 + r;
  u16* uL = (u16*)lw;
  u16* zin = (u16*)(p.ws + OFF_Z) + (size_t)seq * 2048 * 1760;
  u16* mx = (u16*)(p.ws + OFF_H) + (size_t)seq * 2048 * 1024;
  const float* cw = p.in[4] + l * 4 * 256;
  const float cw0 = cw[ch], cw1 = cw[256 + ch], cw2 = cw[512 + ch], cw3 = cw[768 + ch];
  const float cb = p.in[5][l * 256 + ch];
  if (dir == 0) lru_dir<0>(p, l, n, r, h, zin, mx, uL, cw0, cw1, cw2, cw3, cb);
  else lru_dir<1>(p, l, n, r, h, zin, mx, uL, cw0, cw1, cw2, cw3, cb);
}

DI void lru_combine(const Params& p, int seq, int npair, int tid_) {
  int tid = tid_;
  asm volatile("" : "+v"(tid));
  const int sub = tid & 7, trow = tid >> 3;
  const unsigned c0 = npair * 64 + sub * 8;
  const u16* z = (const u16*)(p.ws + OFF_Z) + (size_t)seq * 2048 * 1760;
  u16* mx = (u16*)(p.ws + OFF_H) + (size_t)seq * 2048 * 1024;
#pragma unroll 1
  for (int step = 0; step < 64; step += 8) {
    u32x4 hf[8], hb[8], gt[8];
#pragma unroll
    for (int u = 0; u < 8; u++) {
      const unsigned t = (step + u) * 32 + trow;
      hf[u] = *(const u32x4*)(mx + (t * 1024u + c0));
      hb[u] = *(const u32x4*)(z + (t * 1760u + 512u + c0));
      gt[u] = *(const u32x4*)(z + (t * 1760u + 256u + c0));
    }
#pragma unroll
    for (int u = 0; u < 8; u++) {
      const unsigned t = (step + u) * 32 + trow;
      u32x4 o;
#pragma unroll
      for (int e = 0; e < 4; e++) {
        const float v0 = (bflo(hf[u][e]) + bflo(hb[u][e])) * gelu_tanh(bflo(gt[u][e]));
        const float v1 = (bfhi(hf[u][e]) + bfhi(hb[u][e])) * gelu_tanh(bfhi(gt[u][e]));
        o[e] = pack2(v0, v1);
      }
      *(u32x4*)(mx + (t * 1024u + c0)) = o;
    }
  }
}

template <int DIR>
DI void gla_dir(const Params& p, int l, int head, int lane_, const u16* __restrict__ z, u16* __restrict__ mixed, u16* __restrict__ gt, char* lw) {
  int lane = lane_;
  int r = lane & 31, h = lane >> 5;
  u16* qdL = (u16*)lw;
  u16* kiL = qdL + 1280;
  u16* keT = kiL + 1280;
  u16* vT = keT + 1280;
  float* blastL = (float*)(vT + 2560);
  const int cposr = 16 * (r >> 4) + perm16(r & 15);
  const float qs = 0.17677669529663687f;
  const float* wa2 = p.in[DIR ? 24 : 22] + (size_t)l * 2048;
  bf16x8 bw;
  {
    float wv[8];
#pragma unroll
    for (int j = 0; j < 8; j++) wv[j] = wa2[(8 * h + j) * 128 + head * 32 + r];
    bw = PACK8(wv, 0);
  }
  const float bias = p.in[DIR ? 25 : 23][l * 128 + head * 32 + r];
  const int gcol = DIR ? 1488 : 1472;
  f32x16 zero;
#pragma unroll
  for (int i = 0; i < 16; i++) zero[i] = 0.f;
  f32x16 S0 = zero, S1 = zero;
#pragma unroll 1
  for (int cn = 0; cn < 64; cn++) {
    const int u0 = cn * 32;
    asm volatile("" : "+v"(r), "+v"(h), "+v"(lane));
#define TOK(pu) (DIR ? (2047 - (u0 + (pu))) : (u0 + (pu)))
    const unsigned trow = (unsigned)TOK(r);
    bf16x8 ga = *(const bf16x8*)(z + (trow * 1760u + gcol + 8 * h));
    u16 qraw[16], kraw[16];
#pragma unroll
    for (int i = 0; i < 16; i++) {
      const unsigned tt = (unsigned)TOK(crow(i, h));
      qraw[i] = z[tt * 1760u + 960u + head * 32 + r];
      kraw[i] = z[tt * 1760u + 1088u + head * 32 + r];
    }
    u16 vraw[32];
#pragma unroll
    for (int pu = 0; pu < 32; pu++) vraw[pu] = z[(unsigned)TOK(pu) * 1760u + 1216u + head * 64 + lane];
    f32x16 x = MFMA(ga, bw, zero);
    float b[16];
#pragma unroll
    for (int i = 0; i < 16; i++) {
      const float xx = x[i] + bias;
      const float ls2 = fminf(xx, 0.f) * 1.4426950408889634f - __builtin_amdgcn_logf(1.f + __builtin_amdgcn_exp2f(fabsf(xx) * -1.4426950408889634f));
      b[i] = ls2 * (1.f / 16.f);
    }
    float gs[4], ps[4];
#pragma unroll
    for (int g = 0; g < 4; g++) {
      b[4 * g + 1] += b[4 * g];
      b[4 * g + 2] += b[4 * g + 1];
      b[4 * g + 3] += b[4 * g + 2];
      gs[g] = b[4 * g + 3];
    }
#pragma unroll
    for (int g = 0; g < 4; g++) ps[g] = __shfl_xor(gs[g], 32);
    float run = 0.f;
#pragma unroll
    for (int g = 0; g < 4; g++) {
      const float ev = h ? ps[g] : gs[g];
      const float od = h ? gs[g] : ps[g];
      const float off = run + (h ? ev : 0.f);
#pragma unroll
      for (int e = 0; e < 4; e++) b[4 * g + e] += off;
      run += ev + od;
    }
    const float eblast = __builtin_amdgcn_exp2f(run);
    float qd[16], ki[16], ke[16];
#pragma unroll
    for (int i = 0; i < 16; i++) {
      const float eb = __builtin_amdgcn_exp2f(b[i]);
      const float einv = __builtin_amdgcn_exp2f(-b[i]);
      const float q = bf2f(qraw[i]) * qs, k = bf2f(kraw[i]);
      qd[i] = q * eb;
      ki[i] = k * einv;
      ke[i] = k * einv * eblast;
    }
    __builtin_amdgcn_wave_barrier();
#pragma unroll
    for (int i = 0; i < 16; i++) {
      qdL[crow(i, h) * 40 + cposr] = f2bf(qd[i]);
      kiL[crow(i, h) * 40 + cposr] = f2bf(ki[i]);
    }
    *(bf16x8*)(keT + r * 40 + 8 * h) = PACK8(ke, 0);
    *(bf16x8*)(keT + r * 40 + 16 + 8 * h) = PACK8(ke, 1);
    if (h == 0) blastL[r] = eblast;
#pragma unroll
    for (int q4 = 0; q4 < 4; q4++) {
      unsigned w4[4];
#pragma unroll
      for (int e = 0; e < 4; e++) {
        const int p0 = 8 * q4 + 2 * e, p1 = p0 + 1;
        const int s0 = 16 * (p0 >> 4) + invperm16(p0 & 15), s1 = 16 * (p1 >> 4) + invperm16(p1 & 15);
        w4[e] = (unsigned)vraw[s0] | ((unsigned)vraw[s1] << 16);
      }
      u32x4 wv = {w4[0], w4[1], w4[2], w4[3]};
      *(u32x4*)(vT + lane * 40 + 8 * q4) = wv;
    }
    __builtin_amdgcn_wave_barrier();
    f32x16 sc = zero;
    bf16x8 qB[2], va0[2], va1[2];
#pragma unroll
    for (int s = 0; s < 2; s++) {
      bf16x8 kA = *(const bf16x8*)(kiL + r * 40 + 16 * s + 8 * h);
      qB[s] = *(const bf16x8*)(qdL + r * 40 + 16 * s + 8 * h);
      va0[s] = *(const bf16x8*)(vT + r * 40 + 16 * s + 8 * h);
      va1[s] = *(const bf16x8*)(vT + (32 + r) * 40 + 16 * s + 8 * h);
      sc = MFMA(kA, qB[s], sc);
    }
#pragma unroll
    for (int i = 0; i < 16; i++) sc[i] = (crow(i, h) <= r) ? sc[i] : 0.f;
    f32x16 o0 = zero, o1 = zero;
#pragma unroll
    for (int s = 0; s < 2; s++) {
      bf16x8 pb = PACK8(sc, s);
      o0 = MFMA(va0[s], pb, o0);
      o1 = MFMA(va1[s], pb, o1);
      bf16x8 sA0 = PACK8(S0, s), sA1 = PACK8(S1, s);
      o0 = MFMA(sA0, qB[s], o0);
      o1 = MFMA(sA1, qB[s], o1);
    }
#pragma unroll
    for (int g = 0; g < 4; g++) {
      const float4 dl = *(const float4*)(blastL + 8 * g + 4 * h);
      S0[4 * g] *= dl.x; S0[4 * g + 1] *= dl.y; S0[4 * g + 2] *= dl.z; S0[4 * g + 3] *= dl.w;
      S1[4 * g] *= dl.x; S1[4 * g + 1] *= dl.y; S1[4 * g + 2] *= dl.z; S1[4 * g + 3] *= dl.w;
    }
#pragma unroll
    for (int s = 0; s < 2; s++) {
      bf16x8 keA = *(const bf16x8*)(keT + r * 40 + 16 * s + 8 * h);
      S0 = MFMA(keA, va0[s], S0);
      S1 = MFMA(keA, va1[s], S1);
    }
    u16* orow = mixed + (trow * 1024u);
    if (DIR == 0) {
#pragma unroll
      for (int g = 0; g < 4; g++) {
        uint2 w0, w1;
        w0.x = pack2(o0[4 * g], o0[4 * g + 1]); w0.y = pack2(o0[4 * g + 2], o0[4 * g + 3]);
        w1.x = pack2(o1[4 * g], o1[4 * g + 1]); w1.y = pack2(o1[4 * g + 2], o1[4 * g + 3]);
        *(uint2*)(orow + 8 * g + 4 * h) = w0;
        *(uint2*)(orow + 32 + 8 * g + 4 * h) = w1;
      }
    } else {
      u16* grow = gt + (trow * 256u);
#pragma unroll
      for (int g = 0; g < 4; g++) {
        uint2 w0, w1;
        w0.x = pack2(o0[4 * g], o0[4 * g + 1]); w0.y = pack2(o0[4 * g + 2], o0[4 * g + 3]);
        w1.x = pack2(o1[4 * g], o1[4 * g + 1]); w1.y = pack2(o1[4 * g + 2], o1[4 * g + 3]);
        *(uint2*)(grow + 8 * g + 4 * h) = w0;
        *(uint2*)(grow + 32 + 8 * g + 4 * h) = w1;
      }
    }
#undef TOK
  }
}

DI void gla_wave(const Params& p, int l, int seq, int head, int dir, char* lw, int lane_) {
  int lane = lane_;
  asm volatile("" : "+v"(lane));
  const u16* z = (const u16*)(p.ws + OFF_Z) + (size_t)seq * 2048 * 1760;
  u16* mixed = (u16*)(p.ws + OFF_H) + (size_t)seq * 2048 * 1024 + 768 + head * 64;
  u16* gt = (u16*)(p.ws + OFF_GT) + (size_t)seq * 2048 * 256 + head * 64;
  if (dir == 0) gla_dir<0>(p, l, head, lane, z, mixed, gt, lw);
  else gla_dir<1>(p, l, head, lane, z, mixed, gt, lw);
}

DI void gla_combine(const Params& p, int l, int seq, int hp, int tid_) {
  int tid = tid_;
  asm volatile("" : "+v"(tid));
  const int sub = tid & 7, rloc = tid >> 3;
  const u16* z = (const u16*)(p.ws + OFF_Z) + (size_t)seq * 2048 * 1760;
  u16* mx = (u16*)(p.ws + OFF_H) + (size_t)seq * 2048 * 1024;
  const u16* gt = (const u16*)(p.ws + OFF_GT) + (size_t)seq * 2048 * 256;
  const float* gop = p.in[26] + l * 64 + sub * 8;
  float go[8];
#pragma unroll
  for (int e = 0; e < 8; e++) go[e] = gop[e];
#pragma unroll 1
  for (int step = 0; step < 128; step += 8) {
    u32x4 of[8], ob[8], og[8];
#pragma unroll
    for (int u = 0; u < 8; u++) {
      const unsigned R = (step + u) * 32 + rloc;
      const unsigned t = R >> 1, c0 = (2 * hp + (R & 1)) * 64 + sub * 8;
      of[u] = *(const u32x4*)(mx + (t * 1024u + 768u + c0));
      ob[u] = *(const u32x4*)(gt + (t * 256u + c0));
      og[u] = *(const u32x4*)(z + (t * 1760u + 1504u + c0));
    }
#pragma unroll
    for (int u = 0; u < 8; u++) {
      const unsigned R = (step + u) * 32 + rloc;
      const unsigned t = R >> 1, c0 = (2 * hp + (R & 1)) * 64 + sub * 8;
      float o[8];
      float ss = 0.f;
#pragma unroll
      for (int e = 0; e < 4; e++) {
        o[2 * e] = bflo(of[u][e]) + bflo(ob[u][e]);
        o[2 * e + 1] = bfhi(of[u][e]) + bfhi(ob[u][e]);
        ss += o[2 * e] * o[2 * e] + o[2 * e + 1] * o[2 * e + 1];
      }
      ss += __shfl_xor(ss, 1);
      ss += __shfl_xor(ss, 2);
      ss += __shfl_xor(ss, 4);
      const float rs = rsqrtf(ss * (1.f / 64.f) + EPS);
      u32x4 w;
#pragma unroll
      for (int e = 0; e < 4; e++) {
        const float a0 = bflo(og[u][e]), a1 = bfhi(og[u][e]);
        w[e] = pack2(o[2 * e] * rs * go[2 * e] * a0 * fsig(a0), o[2 * e + 1] * rs * go[2 * e + 1] * a1 * fsig(a1));
      }
      *(u32x4*)(mx + (t * 1024u + 768u + c0)) = w;
    }
  }
}

#define XB_TMO      128
#define XB_XCNT(j)  (256  + 64 * (j))
#define XB_XSUB(j)  (1280 + 64 * (j))
#define XB_XGEN(j)  (2304 + 64 * (j))
#define XB_TOP      3328
#define XB_TOPGEN   3392
#define XCD_BAR_WORDS 3456
#define XB_SPIN_CAP (1u << 18)
DI unsigned xb_ld(unsigned* p) { return __hip_atomic_load(p, __ATOMIC_RELAXED, __HIP_MEMORY_SCOPE_AGENT); }
DI unsigned xb_add(unsigned* p, unsigned v) { return __hip_atomic_fetch_add(p, v, __ATOMIC_RELAXED, __HIP_MEMORY_SCOPE_AGENT); }
DI unsigned xb_xcc_id() { return (unsigned)__builtin_amdgcn_s_getreg((3 << 11) | 20) & 0xFu; }
#define XB_SPIN(cond, bar) do { unsigned _sp = 0; while (cond) { __builtin_amdgcn_s_sleep(1); \
    if ((++_sp & 255u) == 0u) { if (xb_ld(&(bar)[XB_TMO])) break; if (_sp > XB_SPIN_CAP) { atomicAdd(&(bar)[XB_TMO], 1u); break; } } } } while (0)
struct XcdBarrier { unsigned* bar; unsigned x; volatile LAS unsigned* st; };
DI XcdBarrier xcd_barrier_post(unsigned* bar, volatile LAS unsigned* st) {
  XcdBarrier b; b.bar = bar; b.x = xb_xcc_id(); b.st = st;
  if (threadIdx.x == 0) (void)xb_add(&bar[XB_XCNT(b.x)], 1u);
  return b;
}
DI void xcd_barrier_complete(unsigned* bar, unsigned x, unsigned& nloc, unsigned& nx) {
  const unsigned G = gridDim.x * gridDim.y * gridDim.z;
  unsigned sum, cnt, mine, sp = 0u;
  for (;;) {
    sum = 0u; cnt = 0u; mine = 0u;
#pragma unroll
    for (unsigned j = 0; j < 16; ++j) { const unsigned c = xb_ld(&bar[XB_XCNT(j)]); sum += c; cnt += (c > 0u) ? 1u : 0u; mine = (j == x) ? c : mine; }
    if (sum == G) break;
    __builtin_amdgcn_s_sleep(1);
    if ((++sp & 255u) == 0u) { if (xb_ld(&bar[XB_TMO])) break; if (sp > XB_SPIN_CAP) { atomicAdd(&bar[XB_TMO], 1u); break; } }
  }
  nloc = mine > 0u ? mine : 1u; nx = cnt > 0u ? cnt : 1u;
}
DI void xcd_barrier(const XcdBarrier& b) {
  asm volatile("s_waitcnt vmcnt(0)" ::: "memory");
  __syncthreads();
  if (threadIdx.x == 0) {
    unsigned* bar = b.bar;
    __builtin_amdgcn_s_waitcnt(0);
    unsigned nloc = b.st[0], nx = b.st[1];
    if (nloc == 0u) { xcd_barrier_complete(bar, b.x, nloc, nx); b.st[0] = nloc; b.st[1] = nx; }
    const unsigned old = xb_add(&bar[XB_XSUB(b.x)], 1u);
    const unsigned gen = old / nloc;
    if (old + 1u == (gen + 1u) * nloc) {
      __builtin_amdgcn_fence(__ATOMIC_RELEASE, "agent");
      asm volatile("s_waitcnt vmcnt(0)" ::: "memory");
      const unsigned og = xb_add(&bar[XB_TOP], 1u);
      const unsigned tg = og / nx;
      if (og + 1u == (tg + 1u) * nx) xb_add(&bar[XB_TOPGEN], 1u);
      else XB_SPIN(xb_ld(&bar[XB_TOPGEN]) == tg, bar);
      __builtin_amdgcn_fence(__ATOMIC_ACQUIRE, "agent");
      xb_add(&bar[XB_XGEN(b.x)], 1u);
      asm volatile("s_waitcnt vmcnt(0)" ::: "memory");
    } else {
      XB_SPIN(xb_ld(&bar[XB_XGEN(b.x)]) == gen, bar);
      __builtin_amdgcn_fence(__ATOMIC_ACQUIRE, "agent");
      asm volatile("s_waitcnt vmcnt(0)" ::: "memory");
    }
  }
  __syncthreads();
}

DI void run_phase(const Params& p, int ph, char* smem, int* s_item, const XcdBarrier* xbp) {
  const int tid = get_tid();
  if (ph == 0) {
    phase_p0(p, smem);
    for (int it = blockIdx.x; it < T / 128; it += gridDim.x) xb_item(p, 0, (u16*)(p.ws + OFF_XB), (float*)(p.ws + OFF_SSQ), it);
    return;
  }
  const int l = (ph - 1) / 10, sub = (ph - 1) % 10;
  u16* wl = (u16*)(p.ws + OFF_WB) + (size_t)l * WLAYER;
  u16* hb = (u16*)(p.ws + OFF_H);
  u16* z = (u16*)(p.ws + OFF_Z);
  u16* qb = (u16*)(p.ws + OFF_Q);
  u16* hid = (u16*)(p.ws + OFF_HID);
  u16* xb = (u16*)(p.ws + OFF_XB);
  float* ssq = (float*)(p.ws + OFF_SSQ);
  float* sql = (float*)(p.ws + OFF_SQL);
  LAS unsigned char* lds = (LAS unsigned char*)smem;
  switch (sub) {
    case 0:
      if (l == 0)
        for (int it = blockIdx.x; it < T / 128; it += gridDim.x) xb_item(p, 0, xb, ssq, it);
      break;
    case 1: {
      g8::Order S; S.NT = 7; S.C = 7;
      g8::EpiBf16 E; E.c0 = z; E.ldc0 = 1760; E.split_pn = 1000; E.c1 = z; E.ldc1 = 1760; E.nvalid = 1760;
      E.ssq0 = ssq + (size_t)(2 * l) * T; E.inv0 = 1.f / 1024.f; E.ssq1 = nullptr; E.inv1 = 0.f;
      E.sq_a = sql + (size_t)(2 * l) * T; E.sq_b = sql + (size_t)(2 * l + 1) * T;
      g8::gemm_phase(lds, xb, 1024, wl + WIN, 1024, S, E);
    } break;
    case 2:
      break;
    case 3: {
      {
        g8::Order S; S.NT = 3; S.C = 3;
        g8::EpiBf16 E; E.c0 = qb; E.ldc0 = 768; E.split_pn = 1000; E.c1 = qb; E.ldc1 = 768; E.nvalid = 1 << 30;
        E.ssq0 = sql + (size_t)(2 * l) * T; E.inv0 = 1.f / 256.f; E.ssq1 = nullptr; E.inv1 = 0.f; E.sq_a = nullptr; E.sq_b = nullptr;
        g8::gemm_phase(lds, z + 512, 1760, wl + WQKV, 256, S, E);
      }
      {
        g8::Order S; S.NT = 4; S.C = 4;
        g8::EpiBf16 E; E.c0 = hb; E.ldc0 = 1024; E.split_pn = 1000; E.c1 = hb; E.ldc1 = 1024; E.nvalid = 1 << 30;
        E.ssq0 = sql + (size_t)(2 * l + 1) * T; E.inv0 = 1.f / 128.f; E.ssq1 = nullptr; E.inv1 = 0.f; E.sq_a = nullptr; E.sq_b = nullptr;
        g8::gemm_phase(lds, z + 640, 1760, wl + WQKV + (size_t)196608, 256, S, E);
      }
    } break;
    case 4:
      for (int it = blockIdx.x; it < T / 128; it += gridDim.x) prep_item(p, l, it);
      break;
    case 5: {
      int* ctr = (int*)(p.ws + OFF_CTR) + l;
      while (true) {
        __syncthreads();
        if (tid == 0) *s_item = atomicAdd(ctr, 1);
        __syncthreads();
        const int it = __builtin_amdgcn_readfirstlane(*s_item);
        if (it >= 48 + 96 + 1536) break;
        const int wv = __builtin_amdgcn_readfirstlane(tid >> 6);
        const int half = wv >> 2, tl = tid & 255;
        if (it < 48) {
          gla_wave(p, l, it, wv >> 1, wv & 1, smem + wv * 13312, tid & 63);
          __threadfence();
          __syncthreads();
          gla_combine(p, l, it, half, tl);
        } else if (it < 144) {
          const int a = it - 48;
          lru_wave(p, l, a >> 1, 4 * (a & 1) + (wv >> 1), wv & 1, smem + wv * 13312, tid & 63);
          __threadfence();
          __syncthreads();
          lru_combine(p, a >> 1, 2 * (a & 1) + half, tl);
        } else {
          const int a = it - 144;
          attn_item(p, a >> 5, (a >> 3) & 3, a & 7, smem, tid);
        }
      }
    } break;
    case 6: {
      g8::Order S; S.NT = 4; S.C = 4;
      g8::EpiRes E;
      E.xin0 = (l == 0) ? p.in[0] : p.out; E.xin1 = (l == 0) ? p.in[1] - (size_t)65536 * 1024 : p.out;
      E.xout = p.out; E.xb = xb; E.ssq_out = ssq + (size_t)(2 * l + 1) * T;
      g8::gemm_phase(lds, hb, 1024, wl + WOUT, 1024, S, E);
    } break;
    case 7:
      break;
    case 8: {
      for (int c = 0; c < 3; c++) {
        {
          g8::Order S; S.NT = 22; S.C = 6; S.R = 16; S.roff = 16 * c;
          g8::EpiSwiglu E; E.hid = hid; E.ssq = ssq + (size_t)(2 * l + 1) * T;
          g8::gemm_phase(lds, xb, 1024, wl + WFI, 1024, S, E);
        }
        xcd_barrier(*xbp);
        {
          g8::Order S; S.NT = 4; S.C = 4; S.R = 16; S.roff = 16 * c;
          g8::EpiRes E;
          E.xin0 = p.out; E.xin1 = p.out; E.xout = p.out; E.xb = (l == 0) ? xb : nullptr; E.ssq_out = ssq + (size_t)(2 * l + 2) * T;
          g8::gemm_phase(lds, hid, 2816, wl + WFO, 2816, S, E);
        }
        if (c < 2) xcd_barrier(*xbp);
      }
    } break;
    case 9:
      break;
  }
}

__global__ void __launch_bounds__(512, 2) mega(Params p) {
  extern __shared__ __attribute__((aligned(16))) unsigned char lds_dyn[];
  char* smem = (char*)lds_dyn;
  int* s_item = (int*)(smem + SMEM_BYTES);
  cg::grid_group grid = cg::this_grid();
  volatile LAS unsigned* st = (volatile LAS unsigned*)((LAS unsigned char*)lds_dyn + SMEM_BYTES + 16);
  if (threadIdx.x < 2) st[threadIdx.x] = 0u;
  __syncthreads();
  run_phase(p, 0, smem, s_item, nullptr);
  grid.sync();
  XcdBarrier xb = xcd_barrier_post((unsigned*)(p.ws + OFF_BAR), st);
  for (int ph = 1; ph < NPHASE; ph++) {
    if (ph == 1 || ph == 3 || ph == 8 || ph == 10 || ph == 11 || ph == 13 || ph == 18 || ph == 20) continue;
    run_phase(p, ph, smem, s_item, &xb);
    if (ph < 19) xcd_barrier(xb);
  }
}

extern "C" void kernel_launch(void* const* d_in, const int* in_sizes, int n_in, void* d_out, int out_size, void* d_ws,
                              size_t ws_size, hipStream_t stream) {
  Params p{};
  for (int i = 0; i < 31; i++) p.in[i] = (const float*)d_in[i];
  p.out = (float*)d_out;
  p.ws = (char*)d_ws;
  if (ws_size < WS_NEED) { fprintf(stderr, "workspace too small: %zu < %zu\n", ws_size, (size_t)WS_NEED); return; }
  static int grid_blocks = 0;
  if (!grid_blocks) {
    int dev = 0, cus = 0, per_cu = 0;
    (void)hipGetDevice(&dev);
    (void)hipDeviceGetAttribute(&cus, hipDeviceAttributeMultiprocessorCount, dev);
    if (hipFuncSetAttribute((const void*)mega, hipFuncAttributeMaxDynamicSharedMemorySize, LDS_BYTES) != hipSuccess)
      fprintf(stderr, "hipFuncSetAttribute(MaxDynamicSharedMemorySize=%d) failed\n", LDS_BYTES);
    (void)hipOccupancyMaxActiveBlocksPerMultiprocessor(&per_cu, (const void*)mega, 512, LDS_BYTES);
    (void)hipGetLastError();
    grid_blocks = cus;
  }
  void* args[] = {&p};
  hipError_t err = hipLaunchCooperativeKernel((void*)mega, dim3(grid_blocks), dim3(512), args, LDS_BYTES, stream);
  if (err != hipSuccess) fprintf(stderr, "cooperative launch failed: %s (grid %d)\n", hipGetErrorString(err), grid_blocks);
}
```

```cpp
#include <hip/hip_runtime.h>
#include <hip/hip_cooperative_groups.h>
#include <cstdio>
#include <cstdint>
namespace cg = cooperative_groups;

#ifndef MULTI_LAUNCH
#define MULTI_LAUNCH 0
#endif

typedef unsigned short u16;
typedef __attribute__((ext_vector_type(8))) short bf16x8;
typedef __attribute__((ext_vector_type(16))) float f32x16;
typedef unsigned u32x4 __attribute__((ext_vector_type(4)));
typedef __bf16 bf16x2_t __attribute__((ext_vector_type(2)));
typedef float f32x2_t __attribute__((ext_vector_type(2)));
#define DI __device__ __forceinline__
#define MFMA(a, b, c) __builtin_amdgcn_mfma_f32_32x32x16_bf16((a), (b), (c), 0, 0, 0)

constexpr int NSEQ = 48, SEQ = 2048, T = NSEQ * SEQ;
constexpr int DM = 1024, DIN = 1760, DFF = 2816;
constexpr float EPS = 1e-6f;

constexpr size_t WIN = 0, WQKV = 1835008, WOUT = 2523136, WFI = 3571712, WFO = 9338880, WLAYER = 12222464;
constexpr size_t OFF_WB = 0;
constexpr size_t OFF_ROPE = 2 * WLAYER * 2;
constexpr size_t OFF_CTR = OFF_ROPE + 2048 * 32 * 8;
constexpr size_t OFF_H = OFF_CTR + 256;
constexpr size_t OFF_Z = OFF_H + (size_t)T * 1024 * 2;
constexpr size_t OFF_Q = OFF_Z + (size_t)T * 1760 * 2;
constexpr size_t OFF_K = OFF_Q + (size_t)T * 768 * 2;
constexpr size_t OFF_VT = OFF_K + (size_t)T * 768 * 2;
constexpr size_t OFF_GT = OFF_VT + (size_t)T * 512 * 2;
constexpr size_t WS_END = OFF_GT + (size_t)T * 256 * 2;
constexpr size_t OFF_HID = OFF_Z;
constexpr size_t OFF_XB = OFF_HID + (size_t)T * 2816 * 2;
constexpr size_t OFF_SSQ = WS_END;
constexpr size_t OFF_SQL = OFF_SSQ + 4 * (size_t)T * 4;
constexpr size_t OFF_BAR = OFF_SQL + 4 * (size_t)T * 4;
constexpr size_t WS_NEED = OFF_BAR + 16384;
static_assert(OFF_XB + (size_t)T * 1024 * 2 <= WS_END, "xb alias");
static_assert(OFF_HID + (size_t)T * 2816 * 2 <= OFF_VT, "hidden alias");

constexpr int SMEM_BYTES = 131072;
constexpr int LDS_BYTES = SMEM_BYTES + 64;
#define LAS __attribute__((address_space(3)))
typedef float f32x4v __attribute__((ext_vector_type(4)));
constexpr int NPHASE = 21;

struct Params {
  const float* in[31];
  float* out;
  char* ws;
};

DI int get_tid() { int t = threadIdx.x; asm volatile("" : "+v"(t)); return t; }
DI unsigned pack2(float a, float b) {
  f32x2_t v = {a, b};
  bf16x2_t r = __builtin_convertvector(v, bf16x2_t);
  return __builtin_bit_cast(unsigned, r);
}
DI u16 f2bf(float a) { return (u16)(pack2(a, 0.f) & 0xffffu); }
DI float bf2f(u16 v) { return __uint_as_float(((unsigned)v) << 16); }
DI float bflo(unsigned v) { return __uint_as_float(v << 16); }
DI float bfhi(unsigned v) { return __uint_as_float(v & 0xffff0000u); }
DI float wave_sum(float v) {
#pragma unroll
  for (int o = 32; o; o >>= 1) v += __shfl_xor(v, o);
  return v;
}
DI int crow(int i, int h) { return (i & 3) + 8 * (i >> 2) + 4 * h; }
DI float sigmoidf_(float x) { return 1.f / (1.f + __expf(-x)); }
DI float fexp(float x) { return __builtin_amdgcn_exp2f(x * 1.4426950408889634f); }
DI float frcp(float x) { return __builtin_amdgcn_rcpf(x); }
DI float fsig(float x) { return __builtin_amdgcn_rcpf(1.f + __builtin_amdgcn_exp2f(x * -1.4426950408889634f)); }

DI const float* xsrc(const Params& p, int l, size_t row) {
  if (l == 0) return row < 65536 ? p.in[0] + row * 1024 : p.in[1] + (row - 65536) * 1024;
  return p.out + row * 1024;
}

DI void conv_tile(const float* __restrict__ W, int K, int N, u16* __restrict__ Bt, int ldk, int koff, int kt, int nt, int mode, char* smem, const float* __restrict__ gk = nullptr) {
  float* lds = (float*)smem;
  const int tid = get_tid();
  const int k0 = kt * 64, n0 = nt * 64;
  __syncthreads();
#pragma unroll
  for (int i = 0; i < 8; i++) {
    int kk = (tid >> 6) + 8 * i;
    int n = n0 + (tid & 63);
    const int nc = min(n, N - 1);
    float v = W[(size_t)(k0 + kk) * N + nc];
    v = (n < N) ? v : 0.f;
    const float gv = gk ? gk[k0 + kk] : 1.f;
    lds[kk * 65 + (tid & 63)] = v * gv;
  }
  __syncthreads();
  const int c = tid >> 3, ks = (tid & 7) * 8;
  const int n = n0 + c;
  int drow = n;
  if (mode == 1) {
    int j = n < 2816 ? n : n - 2816;
    drow = (j >> 4) * 32 + (n < 2816 ? 0 : 16) + (j & 15);
  }
  unsigned pk[4];
#pragma unroll
  for (int i = 0; i < 4; i++) pk[i] = pack2(lds[(ks + 2 * i) * 65 + c], lds[(ks + 2 * i + 1) * 65 + c]);
  *(uint4*)(Bt + (size_t)drow * ldk + koff + k0 + ks) = make_uint4(pk[0], pk[1], pk[2], pk[3]);
}

DI void phase_p0(const Params& p, char* smem) {
  const int tid = get_tid();
  u16* wb = (u16*)(p.ws + OFF_WB);
  for (int it = blockIdx.x; it < 2 * 2896 + 128; it += gridDim.x) {
    if (it < 2 * 2896) {
      int l = it / 2896, a = it % 2896;
      u16* wl = wb + (size_t)l * WLAYER;
      if (a < 448) { conv_tile(p.in[3] + (size_t)l * 1024 * 1760, 1024, 1760, wl + WIN, 1024, 0, a % 16, a / 16, 0, smem, p.in[2] + l * 1024); }
      else if (a < 496) { a -= 448; conv_tile(p.in[17] + (size_t)l * 256 * 768, 256, 768, wl + WQKV, 256, 0, a % 4, a / 4, 0, smem, p.in[16] + l * 256); }
      else if (a < 528) { a -= 496; conv_tile(p.in[19] + (size_t)l * 128 * 1024, 128, 1024, wl + WQKV + (size_t)196608, 256, 128, a % 2, a / 2, 0, smem, p.in[18] + l * 128); }
      else if (a < 784) { a -= 528; conv_tile(p.in[27] + (size_t)l * 1024 * 1024, 1024, 1024, wl + WOUT, 1024, 0, a % 16, a / 16, 0, smem); }
      else if (a < 2192) { a -= 784; conv_tile(p.in[29] + (size_t)l * 1024 * 5632, 1024, 5632, wl + WFI, 1024, 0, a % 16, a / 16, 1, smem, p.in[28] + l * 1024); }
      else { a -= 2192; conv_tile(p.in[30] + (size_t)l * 2816 * 1024, 2816, 1024, wl + WFO, 2816, 0, a % 44, a / 44, 0, smem); }
    } else {
      int idx = (it - 2 * 2896) * 512 + tid;
      int s = idx >> 5, i = idx & 31;
      float inv = exp2f(-(float)i * (2.0f / 64.0f) * 13.287712379549449f);
      float ang = (float)s * inv;
      float sn, cs;
      sn = sinf(ang); cs = cosf(ang);
      float2* rope = (float2*)(p.ws + OFF_ROPE);
      rope[idx] = make_float2(cs, sn);
    }
  }
  if (blockIdx.x == 0 && tid < 8) ((int*)(p.ws + OFF_CTR))[tid] = 0;
  if (blockIdx.x == 0) { unsigned* bw = (unsigned*)(p.ws + OFF_BAR); for (int i = tid; i < 3456; i += 512) bw[i] = 0u; }
  {
    float* sq = (float*)(p.ws + OFF_SSQ);
    for (int i = T + blockIdx.x * 512 + tid; i < 8 * T; i += gridDim.x * 512) sq[i] = 0.f;
    for (int i = blockIdx.x * 512 + tid; i < 2 * 16384; i += gridDim.x * 512) {
      const int l = i >> 14, v = i & 16383;
      u16* wkv = wb + (size_t)l * WLAYER + WQKV + 196608;
      *(uint4*)(wkv + (size_t)(v >> 4) * 256 + (v & 15) * 8) = make_uint4(0u, 0u, 0u, 0u);
    }
  }
}

DI void xb_item(const Params& p, int lsrc, u16* __restrict__ xb, float* __restrict__ ssq, int item) {
  const int tid = get_tid(), lane = tid & 63, w = tid >> 6;
#pragma unroll 1
  for (int rr = 0; rr < 16; rr += 4) {
    float4 v[4][4];
#pragma unroll
    for (int j = 0; j < 4; j++) {
      const float* xr = xsrc(p, lsrc, (size_t)item * 128 + w * 16 + rr + j);
#pragma unroll
      for (int i = 0; i < 4; i++) v[j][i] = *(const float4*)(xr + 256 * i + 4 * lane);
    }
#pragma unroll
    for (int j = 0; j < 4; j++) {
      const size_t row = (size_t)item * 128 + w * 16 + rr + j;
      float ss = 0.f;
#pragma unroll
      for (int i = 0; i < 4; i++) ss += v[j][i].x * v[j][i].x + v[j][i].y * v[j][i].y + v[j][i].z * v[j][i].z + v[j][i].w * v[j][i].w;
      ss = wave_sum(ss);
      if (lane == 0) ssq[row] = ss;
#pragma unroll
      for (int i = 0; i < 4; i++) {
        uint2 o;
        o.x = pack2(v[j][i].x, v[j][i].y);
        o.y = pack2(v[j][i].z, v[j][i].w);
        *(uint2*)(xb + row * 1024 + 256 * i + 4 * lane) = o;
      }
    }
  }
}

namespace g8 {
constexpr int BM = 256, BK = 64, HALF = 128, HTB = HALF * BK * 2;
DI int lds_byte(int r, int c) { const int st = (r >> 4) * 2 + (c >> 5), rr = r & 15, cc = c & 31, ob = rr * 64 + cc * 2; return st * 1024 + (ob ^ (((ob >> 9) & 1) << 5)); }
DI void stage_rc(int b, int& R, int& C) { const int st = b / 1024, sb = b % 1024, swz = sb ^ (((sb >> 9) & 1) << 5); R = (st >> 1) * 16 + swz / 64; C = (st & 1) * 32 + (swz % 64) / 2; }
DI int perm32(int rho) { const int n = rho >> 4, i = rho & 15; return 8 * (i >> 2) + 4 * n + (i & 3); }
struct Unit { int pm, pn; };
struct Order {
  int NT, C;
  int R = 48, roff = 0;
  DI bool next(int k, Unit& u) const {
    const int g = blockIdx.x & 7, j = blockIdx.x >> 3, J = gridDim.x >> 3;
    const int q = k * J + j;
    if (q >= R * NT) return false;
    const int P = R * C;
    const int pc = q / P, rem = q - pc * P;
    const int cw = min(C, NT - pc * C);
    const int mtl = rem / cw, nc = rem - mtl * cw;
    u.pm = 48 * g + roff + mtl;
    u.pn = pc * C + nc;
    return true;
  }
};

template <class Epi>
DI void gemm_phase(LAS unsigned char* lds, const u16* __restrict__ Aptr, int lda, const u16* __restrict__ Btptr, int K, const Order& S, const Epi& E) {
  const int tid = get_tid(), wid = __builtin_amdgcn_readfirstlane(tid >> 6), lane = tid & 63, wr = wid >> 2, wc = wid & 3, fr = lane & 15, fq = lane >> 4;
  const int nt = K / BK;
  unsigned voffA[2], voffB[2];
#pragma unroll
  for (int i = 0; i < 2; ++i) {
    int R, C;
    stage_rc(tid * 16 + i * 8192, R, C);
    const int Rb = Epi::PERM ? ((R & ~31) + perm32(R & 31)) : R;
    voffA[i] = (unsigned)(R * lda + C) * 2u;
    voffB[i] = (unsigned)(Rb * K + C) * 2u;
  }
  const size_t kstep = (size_t)(BK * 2);
  const size_t hstepA = (size_t)HALF * lda * 2, hstepB = (size_t)HALF * K * 2;
  const size_t tstepA = 2 * hstepA, tstepB = 2 * hstepB;
  const unsigned ldsw = (unsigned)wid * 1024u;
  const int aoff = lds_byte(wr * 64 + fr, fq * 8), boff = lds_byte(wc * 32 + fr, fq * 8);
#define G8_SA(b, h) (((b) * 2 + (h)) * HTB)
#define G8_SB(b, h) ((4 + (b) * 2 + (h)) * HTB)
#define G8_STAGE(bufoff, gbase, voff) do { _Pragma("unroll") for (int _i = 0; _i < 2; ++_i) \
    __builtin_amdgcn_global_load_lds((const unsigned*)((const char*)(gbase) + (voff)[_i]), (LAS unsigned*)(lds + (bufoff) + ldsw + _i * 8192), 16, 0, 0); } while (0)
#define G8_LDA(dst, b, h) do { _Pragma("unroll") for (int m = 0; m < 4; ++m) _Pragma("unroll") for (int k = 0; k < 2; ++k) dst[m][k] = *(const LAS bf16x8*)(lds + G8_SA(b, h) + aoff + m * 2048 + k * 1024); } while (0)
#define G8_LDB(dst, b, h) do { _Pragma("unroll") for (int n = 0; n < 2; ++n) _Pragma("unroll") for (int k = 0; k < 2; ++k) dst[n][k] = *(const LAS bf16x8*)(lds + G8_SB(b, h) + boff + n * 2048 + k * 1024); } while (0)
#define G8_MMA(ai, bj, At, Bt) do { __builtin_amdgcn_s_setprio(1); _Pragma("unroll") for (int m = 0; m < 4; ++m) _Pragma("unroll") for (int n = 0; n < 2; ++n) _Pragma("unroll") for (int k = 0; k < 2; ++k) \
    acc[ai][bj][m][n] = __builtin_amdgcn_mfma_f32_16x16x32_bf16(Bt[n][k], At[m][k], acc[ai][bj][m][n], 0, 0, 0); __builtin_amdgcn_s_setprio(0); } while (0)
#define G8_WAIT_V(n) asm volatile("s_waitcnt vmcnt(" #n ")" ::: "memory")
#define G8_WAIT_L(n) asm volatile("s_waitcnt lgkmcnt(" #n ")" ::: "memory")
#define G8_BAR __builtin_amdgcn_s_barrier()
#define G8_SCHED __builtin_amdgcn_sched_barrier(0)
  Unit cur, nxt;
  int ui = 0;
  if (!S.next(0, cur)) return;
  f32x4v acc[2][2][4][2];
#pragma unroll
  for (int a = 0; a < 2; ++a)
#pragma unroll
    for (int b = 0; b < 2; ++b)
#pragma unroll
      for (int m = 0; m < 4; ++m)
#pragma unroll
        for (int n = 0; n < 2; ++n) acc[a][b][m][n] = (f32x4v){0.f, 0.f, 0.f, 0.f};
  bf16x8 At[4][2], B0[2][2], B1[2][2];
  const char* cA = (const char*)Aptr + (size_t)cur.pm * tstepA;
  const char* cB = (const char*)Btptr + (size_t)cur.pn * tstepB;
  G8_STAGE(G8_SB(0, 0), cB, voffB); G8_STAGE(G8_SA(0, 0), cA, voffA); G8_STAGE(G8_SB(0, 1), cB + hstepB, voffB); G8_STAGE(G8_SA(0, 1), cA + hstepA, voffA);
  if (wr == 1) G8_BAR;
  G8_WAIT_V(4); G8_BAR;
  G8_STAGE(G8_SB(1, 0), cB + kstep, voffB); G8_STAGE(G8_SA(1, 0), cA + kstep, voffA); G8_STAGE(G8_SB(1, 1), cB + hstepB + kstep, voffB);
  G8_WAIT_V(6); G8_BAR;
  for (;;) {
    const bool has_next = S.next(ui + 1, nxt);
    const char* nA = has_next ? (const char*)Aptr + (size_t)nxt.pm * tstepA : cA;
    const char* nB = has_next ? (const char*)Btptr + (size_t)nxt.pn * tstepB : cB;
    for (int t = 0; t < nt; t += 2) {
      const bool last = (t == nt - 2);
      const char* a1 = cA + (size_t)(t + 1) * kstep;
      const char* a2 = last ? nA : cA + (size_t)(t + 2) * kstep;
      const char* b2 = last ? nB : cB + (size_t)(t + 2) * kstep;
      const char* a3 = a2 + kstep;
      const char* b3 = b2 + kstep;
      G8_LDB(B0, 0, 0); G8_SCHED; G8_LDA(At, 0, 0); G8_STAGE(G8_SA(1, 1), a1 + hstepA, voffA);
      G8_WAIT_L(8); G8_BAR; G8_WAIT_L(0); G8_MMA(0, 0, At, B0); G8_BAR; G8_SCHED;
      G8_LDB(B1, 0, 1); G8_STAGE(G8_SB(0, 0), b2, voffB);
      G8_BAR; G8_WAIT_L(0); G8_MMA(0, 1, At, B1); G8_BAR;
      G8_LDA(At, 0, 1); G8_STAGE(G8_SA(0, 0), a2, voffA);
      G8_BAR; G8_WAIT_L(0); G8_MMA(1, 0, At, B0); G8_BAR; G8_SCHED;
      G8_STAGE(G8_SB(0, 1), b2 + hstepB, voffB);
      G8_WAIT_V(6); G8_BAR; G8_MMA(1, 1, At, B1); G8_BAR;
      G8_LDB(B0, 1, 0); G8_SCHED; G8_LDA(At, 1, 0); G8_STAGE(G8_SA(0, 1), a2 + hstepA, voffA);
      G8_WAIT_L(8); G8_BAR; G8_WAIT_L(0); G8_MMA(0, 0, At, B0); G8_BAR; G8_SCHED;
      G8_LDB(B1, 1, 1); G8_STAGE(G8_SB(1, 0), b3, voffB);
      G8_BAR; G8_WAIT_L(0); G8_MMA(0, 1, At, B1); G8_BAR;
      G8_LDA(At, 1, 1); G8_STAGE(G8_SA(1, 0), a3, voffA);
      G8_BAR; G8_WAIT_L(0); G8_MMA(1, 0, At, B0); G8_BAR; G8_SCHED;
      G8_STAGE(G8_SB(1, 1), b3 + hstepB, voffB);
      G8_WAIT_V(6); G8_BAR; G8_MMA(1, 1, At, B1); G8_BAR;
    }
    E(acc, cur, wr, wc, fr, fq);
    if (!has_next) break;
#pragma unroll
    for (int a = 0; a < 2; ++a)
#pragma unroll
      for (int b = 0; b < 2; ++b)
#pragma unroll
        for (int m = 0; m < 4; ++m)
#pragma unroll
          for (int n = 0; n < 2; ++n) acc[a][b][m][n] = (f32x4v){0.f, 0.f, 0.f, 0.f};
    cur = nxt; cA = nA; cB = nB; ++ui;
  }
  G8_WAIT_V(0);
  if (wr == 0) G8_BAR;
  G8_BAR;
#undef G8_SA
#undef G8_SB
#undef G8_STAGE
#undef G8_LDA
#undef G8_LDB
#undef G8_MMA
#undef G8_WAIT_V
#undef G8_WAIT_L
#undef G8_BAR
#undef G8_SCHED
}

struct EpiBf16 {
  static constexpr bool PERM = true;
  u16* c0; int ldc0; int split_pn; u16* c1; int ldc1; int nvalid;
  const float* ssq0; float inv0; const float* ssq1; float inv1;
  float* sq_a; float* sq_b;
  DI void operator()(const f32x4v (&acc)[2][2][4][2], const Unit& u, int wr, int wc, int fr, int fq) const {
    const int row0 = u.pm * BM + wr * 64 + fr;
    u16* base = c0; int ldc = ldc0; int colt = u.pn * BM;
    const float* ssq = ssq0; float inv = inv0;
    if (u.pn >= split_pn) { base = c1; ldc = ldc1; colt -= split_pn * BM; ssq = ssq1; inv = inv1; }
    const int col0 = colt + wc * 32 + 8 * fq;
    float* sqo = nullptr; int nbj = 0;
    if (sq_a) { if (u.pn == 2) { sqo = sq_a; nbj = 2; } else if (u.pn == 3) { sqo = sq_b; nbj = 1; } }
    float rsv[2][4];
#pragma unroll
    for (int ai = 0; ai < 2; ++ai)
#pragma unroll
      for (int m = 0; m < 4; ++m) rsv[ai][m] = ssq ? ssq[row0 + ai * HALF + m * 16] : 0.f;
#pragma unroll
    for (int ai = 0; ai < 2; ++ai)
#pragma unroll
      for (int m = 0; m < 4; ++m) rsv[ai][m] = ssq ? rsqrtf(rsv[ai][m] * inv + EPS) : 1.f;
    float ssv[2][4];
#pragma unroll
    for (int ai = 0; ai < 2; ++ai)
#pragma unroll
      for (int m = 0; m < 4; ++m) {
        const int row = row0 + ai * HALF + m * 16;
        const float rs = rsv[ai][m];
        u16* rowp = base + (size_t)row * ldc + col0;
        float ss = 0.f;
#pragma unroll
        for (int bj = 0; bj < 2; ++bj) {
          if (col0 + bj * HALF < nvalid) {
            const f32x4v v0 = acc[ai][bj][m][0] * rs, v1 = acc[ai][bj][m][1] * rs;
            u32x4 w4 = {pack2(v0[0], v0[1]), pack2(v0[2], v0[3]), pack2(v1[0], v1[1]), pack2(v1[2], v1[3])};
            *(u32x4*)(rowp + bj * HALF) = w4;
            if (bj < nbj) ss += v0[0] * v0[0] + v0[1] * v0[1] + v0[2] * v0[2] + v0[3] * v0[3] + v1[0] * v1[0] + v1[1] * v1[1] + v1[2] * v1[2] + v1[3] * v1[3];
          }
        }
        ssv[ai][m] = ss;
      }
    if (sqo) {
#pragma unroll
      for (int ai = 0; ai < 2; ++ai)
#pragma unroll
        for (int m = 0; m < 4; ++m) {
          float ss = ssv[ai][m];
          ss += __shfl_xor(ss, 16);
          ss += __shfl_xor(ss, 32);
          if (fq == 0) atomicAdd(sqo + row0 + ai * HALF + m * 16, ss);
        }
    }
  }
};
struct EpiSwiglu {
  static constexpr bool PERM = false;
  u16* hid; const float* ssq;
  DI void operator()(const f32x4v (&acc)[2][2][4][2], const Unit& u, int wr, int wc, int fr, int fq) const {
    const int row0 = u.pm * BM + wr * 64 + fr;
    const int col0 = (u.pn * BM + wc * 32) / 2 + 4 * fq;
    float rsv[2][4];
#pragma unroll
    for (int ai = 0; ai < 2; ++ai)
#pragma unroll
      for (int m = 0; m < 4; ++m) rsv[ai][m] = ssq[row0 + ai * HALF + m * 16];
#pragma unroll
    for (int ai = 0; ai < 2; ++ai)
#pragma unroll
      for (int m = 0; m < 4; ++m) {
        const int row = row0 + ai * HALF + m * 16;
        const float rs = rsqrtf(rsv[ai][m] * (1.f / 1024.f) + EPS);
        u16* rowp = hid + (size_t)row * 2816 + col0;
#pragma unroll
        for (int bj = 0; bj < 2; ++bj) {
          float v[4];
#pragma unroll
          for (int q = 0; q < 4; q++) {
            const float gt = acc[ai][bj][m][0][q] * rs, up = acc[ai][bj][m][1][q] * rs;
            v[q] = gt * fsig(gt) * up;
          }
          uint2 o;
          o.x = pack2(v[0], v[1]);
          o.y = pack2(v[2], v[3]);
          *(uint2*)(rowp + bj * 64) = o;
        }
      }
  }
};
struct EpiRes {
  static constexpr bool PERM = false;
  const float* xin0; const float* xin1; float* xout; u16* xb; float* ssq_out;
  DI void operator()(const f32x4v (&acc)[2][2][4][2], const Unit& u, int wr, int wc, int fr, int fq) const {
    const int row0 = u.pm * BM + wr * 64 + fr;
    const int col0 = u.pn * BM + wc * 32 + 4 * fq;
    const float* xin = (row0 < 65536) ? xin0 : xin1;
#pragma unroll
    for (int ai = 0; ai < 2; ++ai) {
      f32x4v xi[4][2][2];
#pragma unroll
      for (int m = 0; m < 4; ++m)
#pragma unroll
        for (int bj = 0; bj < 2; ++bj)
#pragma unroll
          for (int n = 0; n < 2; ++n)
            xi[m][bj][n] = *(const f32x4v*)(xin + (size_t)(row0 + ai * HALF + m * 16) * 1024 + col0 + bj * HALF + n * 16);
      float ssr[4];
#pragma unroll
      for (int m = 0; m < 4; ++m) {
        const size_t row = (size_t)(row0 + ai * HALF + m * 16);
        float ss = 0.f;
#pragma unroll
        for (int bj = 0; bj < 2; ++bj)
#pragma unroll
          for (int n = 0; n < 2; ++n) {
            const int col = col0 + bj * HALF + n * 16;
            const f32x4v xo = xi[m][bj][n] + acc[ai][bj][m][n];
            *(f32x4v*)(xout + row * 1024 + col) = xo;
            if (xb) {
              uint2 o;
              o.x = pack2(xo[0], xo[1]);
              o.y = pack2(xo[2], xo[3]);
              *(uint2*)(xb + row * 1024 + col) = o;
              ss += xo[0] * xo[0] + xo[1] * xo[1] + xo[2] * xo[2] + xo[3] * xo[3];
            }
          }
        ssr[m] = ss;
      }
      if (xb) {
#pragma unroll
        for (int m = 0; m < 4; ++m) {
          float ss = ssr[m];
          ss += __shfl_xor(ss, 16);
          ss += __shfl_xor(ss, 32);
          if (fq == 0) atomicAdd(ssq_out + (size_t)(row0 + ai * HALF + m * 16), ss);
        }
      }
    }
  }
};
}

DI void latent_item(const Params& p, int l, u16* __restrict__ z, int item) {
  const int tid = get_tid(), lane = tid & 63, w = tid >> 6;
  const float* gcq = p.in[16] + l * 256;
  const float* gckv = p.in[18] + l * 128;
  float4 g1 = *(const float4*)(gcq + 4 * lane);
  float2 g2 = *(const float2*)(gckv + 2 * lane);
  for (int rr = 0; rr < 16; rr++) {
    size_t t = (size_t)item * 128 + w * 16 + rr;
    u16* zr = z + t * 1760;
    uint2 a = *(const uint2*)(zr + 512 + 4 * lane);
    unsigned b = *(const unsigned*)(zr + 768 + 2 * lane);
    float a0 = bflo(a.x), a1 = bfhi(a.x), a2 = bflo(a.y), a3 = bfhi(a.y);
    float b0 = bflo(b), b1 = bfhi(b);
    float s1 = wave_sum(a0 * a0 + a1 * a1 + a2 * a2 + a3 * a3);
    float s2 = wave_sum(b0 * b0 + b1 * b1);
    float r1 = rsqrtf(s1 * (1.f / 256.f) + EPS), r2 = rsqrtf(s2 * (1.f / 128.f) + EPS);
    uint2 o;
    o.x = pack2(a0 * r1 * g1.x, a1 * r1 * g1.y);
    o.y = pack2(a2 * r1 * g1.z, a3 * r1 * g1.w);
    *(uint2*)(zr + 512 + 4 * lane) = o;
    *(unsigned*)(zr + 768 + 2 * lane) = pack2(b0 * r2 * g2.x, b1 * r2 * g2.y);
  }
}

DI void prep_item(const Params& p, int l, int item) {
  const int tid = get_tid(), lane = tid & 63, w = tid >> 6;
  u16* qb = (u16*)(p.ws + OFF_Q);
  u16* kb = (u16*)(p.ws + OFF_K);
  u16* vt = (u16*)(p.ws + OFF_VT);
  const u16* kvraw = (const u16*)(p.ws + OFF_H);
  const u16* z = (const u16*)(p.ws + OFF_Z);
  const float2* rope = (const float2*)(p.ws + OFF_ROPE);
  const float* gq = p.in[20] + l * 192;
  const float* gk = p.in[21] + l * 192;
  const float gq0 = gq[lane], gq1 = gq[64 + lane], gq2 = gq[128 + lane];
  const float gk0 = gk[lane], gk1 = gk[64 + lane], gk2 = gk[128 + lane];
  const float QS = 0.07216878364870322f * 1.4426950408889634f;
  const size_t tb = (size_t)item * 128 + w * 16;
  const int seq = (int)(tb >> 11), s0 = (int)(tb & 2047);
#pragma unroll 1
  for (int hd = 0; hd < 4; hd++) {
    unsigned vv[16];
#pragma unroll
    for (int t4 = 0; t4 < 16; t4 += 4) {
      u16 qa[4][3], ka[4][3];
      float2 csa[4];
#pragma unroll
      for (int j = 0; j < 4; j++) {
        const size_t t = tb + t4 + j;
        csa[j] = rope[(s0 + t4 + j) * 32 + (lane & 31)];
        const u16* qr = qb + t * 768 + hd * 192;
        qa[j][0] = qr[lane]; qa[j][1] = qr[64 + lane]; qa[j][2] = qr[128 + lane];
        const u16* kvr = kvraw + t * 1024 + hd * 256;
        ka[j][0] = kvr[lane]; ka[j][1] = kvr[64 + lane]; ka[j][2] = z[t * 1760 + 896 + lane];
        vv[t4 + j] = *(const unsigned*)(kvr + 128 + 2 * lane);
      }
#pragma unroll
      for (int j = 0; j < 4; j++) {
        const size_t t = tb + t4 + j;
        const float2 cs = csa[j];
        u16* qr = qb + t * 768 + hd * 192;
        float q0 = bf2f(qa[j][0]), q1 = bf2f(qa[j][1]), q2 = bf2f(qa[j][2]);
        float ss = wave_sum(q0 * q0 + q1 * q1 + q2 * q2);
        float rs = rsqrtf(ss * (1.f / 192.f) + EPS);
        q0 *= rs * gq0; q1 *= rs * gq1; q2 *= rs * gq2;
        float pr = __shfl_xor(q2, 32);
        float rot = (lane < 32) ? (q2 * cs.x - pr * cs.y) : (q2 * cs.x + pr * cs.y);
        qr[lane] = f2bf(q0 * QS); qr[64 + lane] = f2bf(q1 * QS); qr[128 + lane] = f2bf(rot * QS);
        float k0 = bf2f(ka[j][0]), k1 = bf2f(ka[j][1]), k2 = bf2f(ka[j][2]);
        float ks = wave_sum(k0 * k0 + k1 * k1 + k2 * k2);
        float rk = rsqrtf(ks * (1.f / 192.f) + EPS);
        k0 *= rk * gk0; k1 *= rk * gk1; k2 *= rk * gk2;
        float pk = __shfl_xor(k2, 32);
        float rotk = (lane < 32) ? (k2 * cs.x - pk * cs.y) : (k2 * cs.x + pk * cs.y);
        u16* kr = kb + t * 768 + hd * 192;
        kr[lane] = f2bf(k0); kr[64 + lane] = f2bf(k1); kr[128 + lane] = f2bf(rotk);
      }
    }
#pragma unroll
    for (int e2 = 0; e2 < 2; e2++) {
      unsigned o[8];
#pragma unroll
      for (int pp = 0; pp < 8; pp++) {
        const int p0 = 2 * pp, p1 = 2 * pp + 1;
        const int o0 = ((p0 >> 2) & 1) * 8 + (p0 >> 3) * 4 + (p0 & 3);
        const int o1 = ((p1 >> 2) & 1) * 8 + (p1 >> 3) * 4 + (p1 & 3);
        unsigned lo = e2 ? (vv[o0] >> 16) : (vv[o0] & 0xffffu);
        unsigned hi = e2 ? (vv[o1] >> 16) : (vv[o1] & 0xffffu);
        o[pp] = lo | (hi << 16);
      }
      uint4* dst = (uint4*)(vt + ((size_t)(seq * 4 + hd) * 128 + 2 * lane + e2) * 2048 + s0);
      dst[0] = make_uint4(o[0], o[1], o[2], o[3]);
      dst[1] = make_uint4(o[4], o[5], o[6], o[7]);
    }
  }
}

DI void attn_item(const Params& p, int seq, int hd, int qblk, char* smem, int tid_) {
  const u16* qb = (const u16*)(p.ws + OFF_Q);
  const u16* kb = (const u16*)(p.ws + OFF_K);
  const u16* vt = (const u16*)(p.ws + OFF_VT);
  u16* mixed = (u16*)(p.ws + OFF_H);
  int tid = tid_;
  asm volatile("" : "+v"(tid));
  const int lane = tid & 63, w = tid >> 6, r = lane & 31, h = lane >> 5;
  const size_t qrow = (size_t)seq * 2048 + qblk * 256 + w * 32 + r;
  bf16x8 qf[12];
#pragma unroll
  for (int s = 0; s < 12; s++) qf[s] = *(const bf16x8*)(qb + qrow * 768 + hd * 192 + 16 * s + 8 * h);
  f32x16 o[4];
#pragma unroll
  for (int db = 0; db < 4; db++)
#pragma unroll
    for (int i = 0; i < 16; i++) o[db][i] = 0.f;
  float m = -1e30f, lsum = 0.f;
  const u16* kg = kb + ((size_t)seq * 2048 + (tid >> 3)) * 768 + hd * 192 + (tid & 7) * 8;
  const int kl = (tid >> 3) * 200 + (tid & 7) * 8;
  const u16* vg = vt + ((size_t)(seq * 4 + hd) * 128 + (tid >> 3)) * 2048 + (tid & 7) * 8;
  const int vl = (tid >> 3) * 72 + (tid & 7) * 8;
  u32x4 rk[3], rv[2];
#pragma unroll
  for (int i = 0; i < 3; i++) rk[i] = *(const u32x4*)(kg + 64 * i);
#pragma unroll
  for (int i = 0; i < 2; i++) rv[i] = *(const u32x4*)(vg + (size_t)(64 * i) * 2048);
  __syncthreads();
  {
    u16* sK0 = (u16*)smem;
    u16* sV0 = sK0 + 64 * 200;
#pragma unroll
    for (int i = 0; i < 3; i++) *(u32x4*)(sK0 + kl + 64 * i) = rk[i];
#pragma unroll
    for (int i = 0; i < 2; i++) *(u32x4*)(sV0 + vl + 64 * i * 72) = rv[i];
  }
  __syncthreads();
#pragma unroll
  for (int i = 0; i < 3; i++) rk[i] = *(const u32x4*)(kg + (size_t)64 * 768 + 64 * i);
#pragma unroll
  for (int i = 0; i < 2; i++) rv[i] = *(const u32x4*)(vg + (size_t)(64 * i) * 2048 + 64);
  for (int kt = 0; kt < 32; kt++) {
    const u16* sK = (const u16*)(smem + (kt & 1) * 45056);
    const u16* sV = sK + 64 * 200;
    f32x16 st[2];
#pragma unroll
    for (int kb2 = 0; kb2 < 2; kb2++) {
#pragma unroll
      for (int i = 0; i < 16; i++) st[kb2][i] = 0.f;
#pragma unroll
      for (int s = 0; s < 12; s++) {
        bf16x8 kf = *(const bf16x8*)(sK + (kb2 * 32 + r) * 200 + 16 * s + 8 * h);
        st[kb2] = MFMA(kf, qf[s], st[kb2]);
      }
    }
    float mx = st[0][0];
#pragma unroll
    for (int i = 1; i < 16; i++) mx = fmaxf(mx, st[0][i]);
#pragma unroll
    for (int i = 0; i < 16; i++) mx = fmaxf(mx, st[1][i]);
    mx = fmaxf(mx, __shfl_xor(mx, 32));
    if (__any((fmaxf(m, mx) - m) > 8.f)) {
      const float mnew = fmaxf(m, mx);
      const float alpha = __builtin_amdgcn_exp2f(m - mnew);
      m = mnew;
      lsum *= alpha;
#pragma unroll
      for (int db = 0; db < 4; db++)
#pragma unroll
        for (int i = 0; i < 16; i++) o[db][i] *= alpha;
    }
    float ps = 0.f;
#pragma unroll
    for (int kb2 = 0; kb2 < 2; kb2++)
#pragma unroll
      for (int i = 0; i < 16; i++) {
        float pv = __builtin_amdgcn_exp2f(st[kb2][i] - m);
        st[kb2][i] = pv;
        ps += pv;
      }
    lsum += ps;
#pragma unroll
    for (int kb2 = 0; kb2 < 2; kb2++)
#pragma unroll
      for (int c = 0; c < 2; c++) {
        unsigned pk[4];
#pragma unroll
        for (int j = 0; j < 4; j++) pk[j] = pack2(st[kb2][8 * c + 2 * j], st[kb2][8 * c + 2 * j + 1]);
        u32x4 pu = {pk[0], pk[1], pk[2], pk[3]};
        bf16x8 pf = __builtin_bit_cast(bf16x8, pu);
#pragma unroll
        for (int db = 0; db < 4; db++) {
          bf16x8 vf = *(const bf16x8*)(sV + (32 * db + r) * 72 + (2 * kb2 + c) * 16 + 8 * h);
          o[db] = MFMA(vf, pf, o[db]);
        }
      }
    if (kt + 1 < 32) {
      u16* sKn = (u16*)(smem + ((kt + 1) & 1) * 45056);
      u16* sVn = sKn + 64 * 200;
#pragma unroll
      for (int i = 0; i < 3; i++) *(u32x4*)(sKn + kl + 64 * i) = rk[i];
#pragma unroll
      for (int i = 0; i < 2; i++) *(u32x4*)(sVn + vl + 64 * i * 72) = rv[i];
    }
    __syncthreads();
    if (kt + 2 < 32) {
#pragma unroll
      for (int i = 0; i < 3; i++) rk[i] = *(const u32x4*)(kg + (size_t)(kt + 2) * 64 * 768 + 64 * i);
#pragma unroll
      for (int i = 0; i < 2; i++) rv[i] = *(const u32x4*)(vg + (size_t)(64 * i) * 2048 + (kt + 2) * 64);
    }
  }
  lsum += __shfl_xor(lsum, 32);
  const float inv = 1.f / lsum;
  u16* orow = mixed + qrow * 1024 + 256 + hd * 128;
#pragma unroll
  for (int db = 0; db < 4; db++)
#pragma unroll
    for (int g = 0; g < 4; g++) {
      uint2 ov;
      ov.x = pack2(o[db][4 * g] * inv, o[db][4 * g + 1] * inv);
      ov.y = pack2(o[db][4 * g + 2] * inv, o[db][4 * g + 3] * inv);
      *(uint2*)(orow + 32 * db + 8 * g + 4 * h) = ov;
    }
}

DI float gelu_tanh(float x) {
  float y = 0.7978845608028654f * (x + 0.044715f * x * x * x);
  float e = __builtin_amdgcn_exp2f(y * 2.8853900817779268f);
  float th = 1.f - 2.f * __builtin_amdgcn_rcpf(e + 1.f);
  return 0.5f * x * (1.f + th);
}
DI constexpr int perm16(int o) { return ((o >> 2) & 1) * 8 + (o >> 3) * 4 + (o & 3); }
DI constexpr int invperm16(int q) { return ((q & 7) >> 2) * 8 + (q >> 3) * 4 + (q & 3); }
DI bf16x8 pack8(float a0, float a1, float a2, float a3, float a4, float a5, float a6, float a7) {
  u32x4 u = {pack2(a0, a1), pack2(a2, a3), pack2(a4, a5), pack2(a6, a7)};
  return __builtin_bit_cast(bf16x8, u);
}
#define PACK8(v, s) pack8(v[8 * (s)], v[8 * (s) + 1], v[8 * (s) + 2], v[8 * (s) + 3], v[8 * (s) + 4], v[8 * (s) + 5], v[8 * (s) + 6], v[8 * (s) + 7])

template <int DIR>
DI void lru_dir(const Params& p, int l, int n, int r_, int h_, u16* __restrict__ zb, u16* __restrict__ mb, u16* uL,
                float cw0, float cw1, float cw2, float cw3, float cb) {
  int r = r_, h = h_;
  const int ch = n * 32 + r;
  const float* Wa = p.in[DIR ? 11 : 6] + (size_t)l * 8192 + n * 1024 + r;
  const float* Wx = p.in[DIR ? 13 : 8] + (size_t)l * 8192 + n * 1024 + r;
  bf16x8 bwa[2], bwx[2];
#pragma unroll
  for (int s = 0; s < 2; s++) {
    float a[8], x[8];
#pragma unroll
    for (int j = 0; j < 8; j++) { a[j] = Wa[(16 * s + 8 * h + j) * 32]; x[j] = Wx[(16 * s + 8 * h + j) * 32]; }
    bwa[s] = PACK8(a, 0);
    bwx[s] = PACK8(x, 0);
  }
  const float ba = p.in[DIR ? 12 : 7][l * 256 + ch];
  const float bx = p.in[DIR ? 14 : 9][l * 256 + ch];
  const float lam = p.in[DIR ? 15 : 10][l * 256 + ch];
  const float sp8 = -8.f * (fmaxf(-lam, 0.f) + log1pf(__expf(-fabsf(lam))));
  const float sp8l2 = sp8 * 1.4426950408889634f;
  float Hc = 0.f;
  f32x16 zero;
#pragma unroll
  for (int i = 0; i < 16; i++) zero[i] = 0.f;
  u16 xr[28];
  {
    const int tb0 = (DIR ? 63 : 0) * 32;
#pragma unroll
    for (int g = 0; g < 4; g++)
#pragma unroll
      for (int m = 0; m < 7; m++) {
        const int tt = tb0 + 8 * g + 4 * h - 2 + m;
        const int tc = min(max(tt, 0), 2047);
        xr[7 * g + m] = zb[(unsigned)tc * 1760u + (unsigned)(n * 32 + r)];
      }
  }
#pragma unroll 1
  for (int tl = 0; tl < 64; tl++) {
    const int tile = DIR ? 63 - tl : tl;
    const int tb = tile * 32;
    asm volatile("" : "+v"(r), "+v"(h));
    const unsigned chz = n * 32 + r;
    u16 xn[28];
    {
      const int tln = (tl + 1 < 64) ? tl + 1 : tl;
      const int tbn = (DIR ? 63 - tln : tln) * 32;
#pragma unroll
      for (int g = 0; g < 4; g++)
#pragma unroll
        for (int m = 0; m < 7; m++) {
          const int tt = tbn + 8 * g + 4 * h - 2 + m;
          const int tc = min(max(tt, 0), 2047);
          xn[7 * g + m] = zb[(unsigned)tc * 1760u + chz];
        }
    }
    float uv[16];
#pragma unroll
    for (int g = 0; g < 4; g++) {
      const int t0 = tb + 8 * g + 4 * h;
      float x[7];
#pragma unroll
      for (int m = 0; m < 7; m++) {
        const int tt = t0 - 2 + m;
        x[m] = (tt >= 0 && tt < 2048) ? bf2f(xr[7 * g + m]) : 0.f;
      }
#pragma unroll
      for (int e = 0; e < 4; e++) uv[4 * g + e] = cb + cw0 * x[e] + cw1 * x[e + 1] + cw2 * x[e + 2] + cw3 * x[e + 3];
    }
    __builtin_amdgcn_wave_barrier();
#pragma unroll
    for (int i = 0; i < 16; i++) uL[crow(i, h) * 40 + r] = f2bf(uv[i]);
    __builtin_amdgcn_wave_barrier();
    bf16x8 a0 = *(const bf16x8*)(uL + r * 40 + 8 * h);
    bf16x8 a1 = *(const bf16x8*)(uL + r * 40 + 16 + 8 * h);
    f32x16 rp = MFMA(a0, bwa[0], zero);
    rp = MFMA(a1, bwa[1], rp);
    f32x16 ip = MFMA(a0, bwx[0], zero);
    ip = MFMA(a1, bwx[1], ip);
    float av[16], uu[16];
#pragma unroll
    for (int i = 0; i < 16; i++) {
      const float rg = fsig(rp[i] + ba), ig = fsig(ip[i] + bx);
      const float a = __builtin_amdgcn_exp2f(sp8l2 * rg);
      av[i] = a;
      uu[i] = __builtin_amdgcn_sqrtf(fmaxf(1.f - a * a, 0.f)) * ig * uv[i];
    }
    float gA[4], gB[4];
#pragma unroll
    for (int g = 0; g < 4; g++) {
      if (DIR == 0) {
        gA[g] = av[4 * g] * av[4 * g + 1] * av[4 * g + 2] * av[4 * g + 3];
        gB[g] = ((uu[4 * g] * av[4 * g + 1] + uu[4 * g + 1]) * av[4 * g + 2] + uu[4 * g + 2]) * av[4 * g + 3] + uu[4 * g + 3];
      } else {
        gA[g] = av[4 * g] * av[4 * g + 1] * av[4 * g + 2] * av[4 * g + 3];
        gB[g] = uu[4 * g] + av[4 * g] * (uu[4 * g + 1] + av[4 * g + 1] * (uu[4 * g + 2] + av[4 * g + 2] * uu[4 * g + 3]));
      }
    }
    float pA[4], pB[4];
#pragma unroll
    for (int g = 0; g < 4; g++) { pA[g] = __shfl_xor(gA[g], 32); pB[g] = __shfl_xor(gB[g], 32); }
    float myin[4];
    float sst = Hc;
    if (DIR == 0) {
#pragma unroll
      for (int g = 0; g < 4; g++) {
        const float eA = h ? pA[g] : gA[g], eB = h ? pB[g] : gB[g];
        const float oA = h ? gA[g] : pA[g], oB = h ? gB[g] : pB[g];
        const float ine = sst;
        sst = eA * sst + eB;
        const float ino = sst;
        sst = oA * sst + oB;
        myin[g] = h ? ino : ine;
      }
    } else {
#pragma unroll
      for (int g = 3; g >= 0; g--) {
        const float eA = h ? pA[g] : gA[g], eB = h ? pB[g] : gB[g];
        const float oA = h ? gA[g] : pA[g], oB = h ? gB[g] : pB[g];
        const float ino = sst;
        sst = oA * sst + oB;
        const float ine = sst;
        sst = eA * sst + eB;
        myin[g] = h ? ino : ine;
      }
    }
    Hc = sst;
    float hv[16];
#pragma unroll
    for (int g = 0; g < 4; g++) {
      float hc = myin[g];
      if (DIR == 0) {
#pragma unroll
        for (int e = 0; e < 4; e++) { hc = av[4 * g + e] * hc + uu[4 * g + e]; hv[4 * g + e] = hc; }
      } else {
#pragma unroll
        for (int e = 3; e >= 0; e--) { hc = av[4 * g + e] * hc + uu[4 * g + e]; hv[4 * g + e] = hc; }
      }
    }
#pragma unroll
    for (int i = 0; i < 16; i++) {
      const int tt = tb + crow(i, h);
      if (DIR == 0) mb[(unsigned)tt * 1024u + chz] = f2bf(hv[i]);
      else zb[(unsigned)tt * 1760u + 512u + chz] = f2bf(hv[i]);
    }
#pragma unroll
    for (int i = 0; i < 28; i++) xr[i] = xn[i];
  }
}

DI void lru_wave(const Params& p, int l, int seq, int n, int dir, char* lw, int lane_) {
  int lane = lane_;
  asm volatile("" : "+v"(lane));
  const int r = lane & 31, h = lane >> 5;
  const int ch = n * 32 + r;
  u16* uL = (u16*)lw;
  u16* zin = (u16*)(p.ws + OFF_Z) + (size_t)seq * 2048 * 1760;
  u16* mx = (u16*)(p.ws + OFF_H) + (size_t)seq * 2048 * 1024;
  const float* cw = p.in[4] + l * 4 * 256;
  const float cw0 = cw[ch], cw1 = cw[256 + ch], cw2 = cw[512 + ch], cw3 = cw[768 + ch];
  const float cb = p.in[5][l * 256 + ch];
  if (dir == 0) lru_dir<0>(p, l, n, r, h, zin, mx, uL, cw0, cw1, cw2, cw3, cb);
  else lru_dir<1>(p, l, n, r, h, zin, mx, uL, cw0, cw1, cw2, cw3, cb);
}

DI void lru_combine(const Params& p, int seq, int npair, int tid_) {
  int tid = tid_;
  asm volatile("" : "+v"(tid));
  const int sub = tid & 7, trow = tid >> 3;
  const unsigned c0 = npair * 64 + sub * 8;
  const u16* z = (const u16*)(p.ws + OFF_Z) + (size_t)seq * 2048 * 1760;
  u16* mx = (u16*)(p.ws + OFF_H) + (size_t)seq * 2048 * 1024;
#pragma unroll 1
  for (int step = 0; step < 64; step += 8) {
    u32x4 hf[8], hb[8], gt[8];
#pragma unroll
    for (int u = 0; u < 8; u++) {
      const unsigned t = (step + u) * 32 + trow;
      hf[u] = *(const u32x4*)(mx + (t * 1024u + c0));
      hb[u] = *(const u32x4*)(z + (t * 1760u + 512u + c0));
      gt[u] = *(const u32x4*)(z + (t * 1760u + 256u + c0));
    }
#pragma unroll
    for (int u = 0; u < 8; u++) {
      const unsigned t = (step + u) * 32 + trow;
      u32x4 o;
#pragma unroll
      for (int e = 0; e < 4; e++) {
        const float v0 = (bflo(hf[u][e]) + bflo(hb[u][e])) * gelu_tanh(bflo(gt[u][e]));
        const float v1 = (bfhi(hf[u][e]) + bfhi(hb[u][e])) * gelu_tanh(bfhi(gt[u][e]));
        o[e] = pack2(v0, v1);
      }
      *(u32x4*)(mx + (t * 1024u + c0)) = o;
    }
  }
}

template <int DIR>
DI void gla_dir(const Params& p, int l, int head, int lane_, const u16* __restrict__ z, u16* __restrict__ mixed, u16* __restrict__ gt, char* lw) {
  int lane = lane_;
  int r = lane & 31, h = lane >> 5;
  u16* qdL = (u16*)lw;
  u16* kiL = qdL + 1280;
  u16* keT = kiL + 1280;
  u16* vT = keT + 1280;
  float* blastL = (float*)(vT + 2560);
  const int cposr = 16 * (r >> 4) + perm16(r & 15);
  const float qs = 0.17677669529663687f;
  const float* wa2 = p.in[DIR ? 24 : 22] + (size_t)l * 2048;
  bf16x8 bw;
  {
    float wv[8];
#pragma unroll
    for (int j = 0; j < 8; j++) wv[j] = wa2[(8 * h + j) * 128 + head * 32 + r];
    bw = PACK8(wv, 0);
  }
  const float bias = p.in[DIR ? 25 : 23][l * 128 + head * 32 + r];
  const int gcol = DIR ? 1488 : 1472;
  f32x16 zero;
#pragma unroll
  for (int i = 0; i < 16; i++) zero[i] = 0.f;
  f32x16 S0 = zero, S1 = zero;
#pragma unroll 1
  for (int cn = 0; cn < 64; cn++) {
    const int u0 = cn * 32;
    asm volatile("" : "+v"(r), "+v"(h), "+v"(lane));
#define TOK(pu) (DIR ? (2047 - (u0 + (pu))) : (u0 + (pu)))
    const unsigned trow = (unsigned)TOK(r);
    bf16x8 ga = *(const bf16x8*)(z + (trow * 1760u + gcol + 8 * h));
    u16 qraw[16], kraw[16];
#pragma unroll
    for (int i = 0; i < 16; i++) {
      const unsigned tt = (unsigned)TOK(crow(i, h));
      qraw[i] = z[tt * 1760u + 960u + head * 32 + r];
      kraw[i] = z[tt * 1760u + 1088u + head * 32 + r];
    }
    u16 vraw[32];
#pragma unroll
    for (int pu = 0; pu < 32; pu++) vraw[pu] = z[(unsigned)TOK(pu) * 1760u + 1216u + head * 64 + lane];
    f32x16 x = MFMA(ga, bw, zero);
    float b[16];
#pragma unroll
    for (int i = 0; i < 16; i++) {
      const float xx = x[i] + bias;
      const float ls2 = fminf(xx, 0.f) * 1.4426950408889634f - __builtin_amdgcn_logf(1.f + __builtin_amdgcn_exp2f(fabsf(xx) * -1.4426950408889634f));
      b[i] = ls2 * (1.f / 16.f);
    }
    float gs[4], ps[4];
#pragma unroll
    for (int g = 0; g < 4; g++) {
      b[4 * g + 1] += b[4 * g];
      b[4 * g + 2] += b[4 * g + 1];
      b[4 * g + 3] += b[4 * g + 2];
      gs[g] = b[4 * g + 3];
    }
#pragma unroll
    for (int g = 0; g < 4; g++) ps[g] = __shfl_xor(gs[g], 32);
    float run = 0.f;
#pragma unroll
    for (int g = 0; g < 4; g++) {
      const float ev = h ? ps[g] : gs[g];
      const float od = h ? gs[g] : ps[g];
      const float off = run + (h ? ev : 0.f);
#pragma unroll
      for (int e = 0; e < 4; e++) b[4 * g + e] += off;
      run += ev + od;
    }
    const float eblast = __builtin_amdgcn_exp2f(run);
    float qd[16], ki[16], ke[16];
#pragma unroll
    for (int i = 0; i < 16; i++) {
      const float eb = __builtin_amdgcn_exp2f(b[i]);
      const float einv = __builtin_amdgcn_exp2f(-b[i]);
      const float q = bf2f(qraw[i]) * qs, k = bf2f(kraw[i]);
      qd[i] = q * eb;
      ki[i] = k * einv;
      ke[i] = k * einv * eblast;
    }
    __builtin_amdgcn_wave_barrier();
#pragma unroll
    for (int i = 0; i < 16; i++) {
      qdL[crow(i, h) * 40 + cposr] = f2bf(qd[i]);
      kiL[crow(i, h) * 40 + cposr] = f2bf(ki[i]);
    }
    *(bf16x8*)(keT + r * 40 + 8 * h) = PACK8(ke, 0);
    *(bf16x8*)(keT + r * 40 + 16 + 8 * h) = PACK8(ke, 1);
    if (h == 0) blastL[r] = eblast;
#pragma unroll
    for (int q4 = 0; q4 < 4; q4++) {
      unsigned w4[4];
#pragma unroll
      for (int e = 0; e < 4; e++) {
        const int p0 = 8 * q4 + 2 * e, p1 = p0 + 1;
        const int s0 = 16 * (p0 >> 4) + invperm16(p0 & 15), s1 = 16 * (p1 >> 4) + invperm16(p1 & 15);
        w4[e] = (unsigned)vraw[s0] | ((unsigned)vraw[s1] << 16);
      }
      u32x4 wv = {w4[0], w4[1], w4[2], w4[3]};
      *(u32x4*)(vT + lane * 40 + 8 * q4) = wv;
    }
    __builtin_amdgcn_wave_barrier();
    f32x16 sc = zero;
    bf16x8 qB[2], va0[2], va1[2];
#pragma unroll
    for (int s = 0; s < 2; s++) {
      bf16x8 kA = *(const bf16x8*)(kiL + r * 40 + 16 * s + 8 * h);
      qB[s] = *(const bf16x8*)(qdL + r * 40 + 16 * s + 8 * h);
      va0[s] = *(const bf16x8*)(vT + r * 40 + 16 * s + 8 * h);
      va1[s] = *(const bf16x8*)(vT + (32 + r) * 40 + 16 * s + 8 * h);
      sc = MFMA(kA, qB[s], sc);
    }
#pragma unroll
    for (int i = 0; i < 16; i++) sc[i] = (crow(i, h) <= r) ? sc[i] : 0.f;
    f32x16 o0 = zero, o1 = zero;
#pragma unroll
    for (int s = 0; s < 2; s++) {
      bf16x8 pb = PACK8(sc, s);
      o0 = MFMA(va0[s], pb, o0);
      o1 = MFMA(va1[s], pb, o1);
      bf16x8 sA0 = PACK8(S0, s), sA1 = PACK8(S1, s);
      o0 = MFMA(sA0, qB[s], o0);
      o1 = MFMA(sA1, qB[s], o1);
    }
#pragma unroll
    for (int g = 0; g < 4; g++) {
      const float4 dl = *(const float4*)(blastL + 8 * g + 4 * h);
      S0[4 * g] *= dl.x; S0[4 * g + 1] *= dl.y; S0[4 * g + 2] *= dl.z; S0[4 * g + 3] *= dl.w;
      S1[4 * g] *= dl.x; S1[4 * g + 1] *= dl.y; S1[4 * g + 2] *= dl.z; S1[4 * g + 3] *= dl.w;
    }
#pragma unroll
    for (int s = 0; s < 2; s++) {
      bf16x8 keA = *(const bf16x8*)(keT + r * 40 + 16 * s + 8 * h);
      S0 = MFMA(keA, va0[s], S0);
      S1 = MFMA(keA, va1[s], S1);
    }
    u16* orow = mixed + (trow * 1024u);
    if (DIR == 0) {
#pragma unroll
      for (int g = 0; g < 4; g++) {
        uint2 w0, w1;
        w0.x = pack2(o0[4 * g], o0[4 * g + 1]); w0.y = pack2(o0[4 * g + 2], o0[4 * g + 3]);
        w1.x = pack2(o1[4 * g], o1[4 * g + 1]); w1.y = pack2(o1[4 * g + 2], o1[4 * g + 3]);
        *(uint2*)(orow + 8 * g + 4 * h) = w0;
        *(uint2*)(orow + 32 + 8 * g + 4 * h) = w1;
      }
    } else {
      u16* grow = gt + (trow * 256u);
#pragma unroll
      for (int g = 0; g < 4; g++) {
        uint2 w0, w1;
        w0.x = pack2(o0[4 * g], o0[4 * g + 1]); w0.y = pack2(o0[4 * g + 2], o0[4 * g + 3]);
        w1.x = pack2(o1[4 * g], o1[4 * g + 1]); w1.y = pack2(o1[4 * g + 2], o1[4 * g + 3]);
        *(uint2*)(grow + 8 * g + 4 * h) = w0;
        *(uint2*)(grow + 32 + 8 * g + 4 * h) = w1;
      }
    }
#undef TOK
  }
}

DI void gla_wave(const Params& p, int l, int seq, int head, int dir, char* lw, int lane_) {
  int lane = lane_;
  asm volatile("" : "+v"(lane));
  const u16* z = (const u16*)(p.ws + OFF_Z) + (size_t)seq * 2048 * 1760;
  u16* mixed = (u16*)(p.ws + OFF_H) + (size_t)seq * 2048 * 1024 + 768 + head * 64;
  u16* gt = (u16*)(p.ws + OFF_GT) + (size_t)seq * 2048 * 256 + head * 64;
  if (dir == 0) gla_dir<0>(p, l, head, lane, z, mixed, gt, lw);
  else gla_dir<1>(p, l, head, lane, z, mixed, gt, lw);
}

DI void gla_combine(const Params& p, int l, int seq, int hp, int tid_) {
  int tid = tid_;
  asm volatile("" : "+v"(tid));
  const int sub = tid & 7, rloc = tid >> 3;
  const u16* z = (const u16*)(p.ws + OFF_Z) + (size_t)seq * 2048 * 1760;
  u16* mx = (u16*)(p.ws + OFF_H) + (size_t)seq * 2048 * 1024;
  const u16* gt = (const u16*)(p.ws + OFF_GT) + (size_t)seq * 2048 * 256;
  const float* gop = p.in[26] + l * 64 + sub * 8;
  float go[8];
#pragma unroll
  for (int e = 0; e < 8; e++) go[e] = gop[e];
#pragma unroll 1
  for (int step = 0; step < 128; step += 8) {
    u32x4 of[8], ob[8], og[8];
#pragma unroll
    for (int u = 0; u < 8; u++) {
      const unsigned R = (step + u) * 32 + rloc;
      const unsigned t = R >> 1, c0 = (2 * hp + (R & 1)) * 64 + sub * 8;
      of[u] = *(const u32x4*)(mx + (t * 1024u + 768u + c0));
      ob[u] = *(const u32x4*)(gt + (t * 256u + c0));
      og[u] = *(const u32x4*)(z + (t * 1760u + 1504u + c0));
    }
#pragma unroll
    for (int u = 0; u < 8; u++) {
      const unsigned R = (step + u) * 32 + rloc;
      const unsigned t = R >> 1, c0 = (2 * hp + (R & 1)) * 64 + sub * 8;
      float o[8];
      float ss = 0.f;
#pragma unroll
      for (int e = 0; e < 4; e++) {
        o[2 * e] = bflo(of[u][e]) + bflo(ob[u][e]);
        o[2 * e + 1] = bfhi(of[u][e]) + bfhi(ob[u][e]);
        ss += o[2 * e] * o[2 * e] + o[2 * e + 1] * o[2 * e + 1];
      }
      ss += __shfl_xor(ss, 1);
      ss += __shfl_xor(ss, 2);
      ss += __shfl_xor(ss, 4);
      const float rs = rsqrtf(ss * (1.f / 64.f) + EPS);
      u32x4 w;
#pragma unroll
      for (int e = 0; e < 4; e++) {
        const float a0 = bflo(og[u][e]), a1 = bfhi(og[u][e]);
        w[e] = pack2(o[2 * e] * rs * go[2 * e] * a0 * fsig(a0), o[2 * e + 1] * rs * go[2 * e + 1] * a1 * fsig(a1));
      }
      *(u32x4*)(mx + (t * 1024u + 768u + c0)) = w;
    }
  }
}

#define XB_TMO      128
#define XB_XCNT(j)  (256  + 64 * (j))
#define XB_XSUB(j)  (1280 + 64 * (j))
#define XB_XGEN(j)  (2304 + 64 * (j))
#define XB_TOP      3328
#define XB_TOPGEN   3392
#define XCD_BAR_WORDS 3456
#define XB_SPIN_CAP (1u << 18)
DI unsigned xb_ld(unsigned* p) { return __hip_atomic_load(p, __ATOMIC_RELAXED, __HIP_MEMORY_SCOPE_AGENT); }
DI unsigned xb_add(unsigned* p, unsigned v) { return __hip_atomic_fetch_add(p, v, __ATOMIC_RELAXED, __HIP_MEMORY_SCOPE_AGENT); }
DI unsigned xb_xcc_id() { return (unsigned)__builtin_amdgcn_s_getreg((3 << 11) | 20) & 0xFu; }
#define XB_SPIN(cond, bar) do { unsigned _sp = 0; while (cond) { __builtin_amdgcn_s_sleep(1); \
    if ((++_sp & 255u) == 0u) { if (xb_ld(&(bar)[XB_TMO])) break; if (_sp > XB_SPIN_CAP) { atomicAdd(&(bar)[XB_TMO], 1u); break; } } } } while (0)
struct XcdBarrier { unsigned* bar; unsigned x; volatile LAS unsigned* st; };
DI XcdBarrier xcd_barrier_post(unsigned* bar, volatile LAS unsigned* st) {
  XcdBarrier b; b.bar = bar; b.x = xb_xcc_id(); b.st = st;
  if (threadIdx.x == 0) (void)xb_add(&bar[XB_XCNT(b.x)], 1u);
  return b;
}
DI void xcd_barrier_complete(unsigned* bar, unsigned x, unsigned& nloc, unsigned& nx) {
  const unsigned G = gridDim.x * gridDim.y * gridDim.z;
  unsigned sum, cnt, mine, sp = 0u;
  for (;;) {
    sum = 0u; cnt = 0u; mine = 0u;
#pragma unroll
    for (unsigned j = 0; j < 16; ++j) { const unsigned c = xb_ld(&bar[XB_XCNT(j)]); sum += c; cnt += (c > 0u) ? 1u : 0u; mine = (j == x) ? c : mine; }
    if (sum == G) break;
    __builtin_amdgcn_s_sleep(1);
    if ((++sp & 255u) == 0u) { if (xb_ld(&bar[XB_TMO])) break; if (sp > XB_SPIN_CAP) { atomicAdd(&bar[XB_TMO], 1u); break; } }
  }
  nloc = mine > 0u ? mine : 1u; nx = cnt > 0u ? cnt : 1u;
}
DI void xcd_barrier(const XcdBarrier& b) {
  asm volatile("s_waitcnt vmcnt(0)" ::: "memory");
  __syncthreads();
  if (threadIdx.x == 0) {
    unsigned* bar = b.bar;
    __builtin_amdgcn_s_waitcnt(0);
    unsigned nloc = b.st[0], nx = b.st[1];
    if (nloc == 0u) { xcd_barrier_complete(bar, b.x, nloc, nx); b.st[0] = nloc; b.st[1] = nx; }
    const unsigned old = xb_add(&bar[XB_XSUB(b.x)], 1u);
    const unsigned gen = old / nloc;
    if (old + 1u == (gen + 1u) * nloc) {
      __builtin_amdgcn_fence(__ATOMIC_RELEASE, "agent");
      asm volatile("s_waitcnt vmcnt(0)" ::: "memory");
      const unsigned og = xb_add(&bar[XB_TOP], 1u);
      const unsigned tg = og / nx;
      if (og + 1u == (tg + 1u) * nx) xb_add(&bar[XB_TOPGEN], 1u);
      else XB_SPIN(xb_ld(&bar[XB_TOPGEN]) == tg, bar);
      __builtin_amdgcn_fence(__ATOMIC_ACQUIRE, "agent");
      xb_add(&bar[XB_XGEN(b.x)], 1u);
      asm volatile("s_waitcnt vmcnt(0)" ::: "memory");
    } else {
      XB_SPIN(xb_ld(&bar[XB_XGEN(b.x)]) == gen, bar);
      __builtin_amdgcn_fence(__ATOMIC_ACQUIRE, "agent");
      asm volatile("s_waitcnt vmcnt(0)" ::: "memory");
    }
  }
  __syncthreads();
}

DI void run_phase(const Params& p, int ph, char* smem, int* s_item, const XcdBarrier* xbp) {
  const int tid = get_tid();
  if (ph == 0) {
    phase_p0(p, smem);
    for (int it = blockIdx.x; it < T / 128; it += gridDim.x) xb_item(p, 0, (u16*)(p.ws + OFF_XB), (float*)(p.ws + OFF_SSQ), it);
    return;
  }
  const int l = (ph - 1) / 10, sub = (ph - 1) % 10;
  u16* wl = (u16*)(p.ws + OFF_WB) + (size_t)l * WLAYER;
  u16* hb = (u16*)(p.ws + OFF_H);
  u16* z = (u16*)(p.ws + OFF_Z);
  u16* qb = (u16*)(p.ws + OFF_Q);
  u16* hid = (u16*)(p.ws + OFF_HID);
  u16* xb = (u16*)(p.ws + OFF_XB);
  float* ssq = (float*)(p.ws + OFF_SSQ);
  float* sql = (float*)(p.ws + OFF_SQL);
  LAS unsigned char* lds = (LAS unsigned char*)smem;
  switch (sub) {
    case 0:
      if (l == 0)
        for (int it = blockIdx.x; it < T / 128; it += gridDim.x) xb_item(p, 0, xb, ssq, it);
      break;
    case 1: {
      g8::Order S; S.NT = 7; S.C = 7;
      g8::EpiBf16 E; E.c0 = z; E.ldc0 = 1760; E.split_pn = 1000; E.c1 = z; E.ldc1 = 1760; E.nvalid = 1760;
      E.ssq0 = ssq + (size_t)(2 * l) * T; E.inv0 = 1.f / 1024.f; E.ssq1 = nullptr; E.inv1 = 0.f;
      E.sq_a = sql + (size_t)(2 * l) * T; E.sq_b = sql + (size_t)(2 * l + 1) * T;
      g8::gemm_phase(lds, xb, 1024, wl + WIN, 1024, S, E);
    } break;
    case 2:
      break;
    case 3: {
      {
        g8::Order S; S.NT = 3; S.C = 3;
        g8::EpiBf16 E; E.c0 = qb; E.ldc0 = 768; E.split_pn = 1000; E.c1 = qb; E.ldc1 = 768; E.nvalid = 1 << 30;
        E.ssq0 = sql + (size_t)(2 * l) * T; E.inv0 = 1.f / 256.f; E.ssq1 = nullptr; E.inv1 = 0.f; E.sq_a = nullptr; E.sq_b = nullptr;
        g8::gemm_phase(lds, z + 512, 1760, wl + WQKV, 256, S, E);
      }
      {
        g8::Order S; S.NT = 4; S.C = 4;
        g8::EpiBf16 E; E.c0 = hb; E.ldc0 = 1024; E.split_pn = 1000; E.c1 = hb; E.ldc1 = 1024; E.nvalid = 1 << 30;
        E.ssq0 = sql + (size_t)(2 * l + 1) * T; E.inv0 = 1.f / 128.f; E.ssq1 = nullptr; E.inv1 = 0.f; E.sq_a = nullptr; E.sq_b = nullptr;
        g8::gemm_phase(lds, z + 640, 1760, wl + WQKV + (size_t)196608, 256, S, E);
      }
    } break;
    case 4:
      for (int it = blockIdx.x; it < T / 128; it += gridDim.x) prep_item(p, l, it);
      break;
    case 5: {
      int* ctr = (int*)(p.ws + OFF_CTR) + l;
      while (true) {
        __syncthreads();
        if (tid == 0) *s_item = atomicAdd(ctr, 1);
        __syncthreads();
        const int it = __builtin_amdgcn_readfirstlane(*s_item);
        if (it >= 48 + 96 + 1536) break;
        const int wv = __builtin_amdgcn_readfirstlane(tid >> 6);
        const int half = wv >> 2, tl = tid & 255;
        if (it < 48) {
          gla_wave(p, l, it, wv >> 1, wv & 1, smem + wv * 13312, tid & 63);
          __threadfence();
          __syncthreads();
          gla_combine(p, l, it, half, tl);
        } else if (it < 144) {
          const int a = it - 48;
          lru_wave(p, l, a >> 1, 4 * (a & 1) + (wv >> 1), wv & 1, smem + wv * 13312, tid & 63);
          __threadfence();
          __syncthreads();
          lru_combine(p, a >> 1, 2 * (a & 1) + half, tl);
        } else {
          const int a = it - 144;
          attn_item(p, a >> 5, (a >> 3) & 3, a & 7, smem, tid);
        }
      }
    } break;
    case 6: {
      g8::Order S; S.NT = 4; S.C = 4;
      g8::EpiRes E;
      E.xin0 = (l == 0) ? p.in[0] : p.out; E.xin1 = (l == 0) ? p.in[1] - (size_t)65536 * 1024 : p.out;
      E.xout = p.out; E.xb = xb; E.ssq_out = ssq + (size_t)(2 * l + 1) * T;
      g8::gemm_phase(lds, hb, 1024, wl + WOUT, 1024, S, E);
    } break;
    case 7:
      break;
    case 8: {
      for (int c = 0; c < 3; c++) {
        {
          g8::Order S; S.NT = 22; S.C = 6; S.R = 16; S.roff = 16 * c;
          g8::EpiSwiglu E; E.hid = hid; E.ssq = ssq + (size_t)(2 * l + 1) * T;
          g8::gemm_phase(lds, xb, 1024, wl + WFI, 1024, S, E);
        }
        xcd_barrier(*xbp);
        {
          g8::Order S; S.NT = 4; S.C = 4; S.R = 16; S.roff = 16 * c;
          g8::EpiRes E;
          E.xin0 = p.out; E.xin1 = p.out; E.xout = p.out; E.xb = (l == 0) ? xb : nullptr; E.ssq_out = ssq + (size_t)(2 * l + 2) * T;
          g8::gemm_phase(lds, hid, 2816, wl + WFO, 2816, S, E);
        }
      }
    } break;
    case 9:
      break;
  }
}

__global__ void __launch_bounds__(512, 2) mega(Params p) {
  extern __shared__ __attribute__((aligned(16))) unsigned char lds_dyn[];
  char* smem = (char*)lds_dyn;
  int* s_item = (int*)(smem + SMEM_BYTES);
  cg::grid_group grid = cg::this_grid();
  volatile LAS unsigned* st = (volatile LAS unsigned*)((LAS unsigned char*)lds_dyn + SMEM_BYTES + 16);
  if (threadIdx.x < 2) st[threadIdx.x] = 0u;
  __syncthreads();
  run_phase(p, 0, smem, s_item, nullptr);
  grid.sync();
  XcdBarrier xb = xcd_barrier_post((unsigned*)(p.ws + OFF_BAR), st);
  for (int ph = 1; ph < NPHASE; ph++) {
    if (ph == 1 || ph == 3 || ph == 8 || ph == 10 || ph == 11 || ph == 13 || ph == 18 || ph == 20) continue;
    run_phase(p, ph, smem, s_item, &xb);
    if (ph < 19) xcd_barrier(xb);
  }
}

extern "C" void kernel_launch(void* const* d_in, const int* in_sizes, int n_in, void* d_out, int out_size, void* d_ws,
                              size_t ws_size, hipStream_t stream) {
  Params p{};
  for (int i = 0; i < 31; i++) p.in[i] = (const float*)d_in[i];
  p.out = (float*)d_out;
  p.ws = (char*)d_ws;
  if (ws_size < WS_NEED) { fprintf(stderr, "workspace too small: %zu < %zu\n", ws_size, (size_t)WS_NEED); return; }
  static int grid_blocks = 0;
  if (!grid_blocks) {
    int dev = 0, cus = 0, per_cu = 0;
    (void)hipGetDevice(&dev);
    (void)hipDeviceGetAttribute(&cus, hipDeviceAttributeMultiprocessorCount, dev);
    if (hipFuncSetAttribute((const void*)mega, hipFuncAttributeMaxDynamicSharedMemorySize, LDS_BYTES) != hipSuccess)
      fprintf(stderr, "hipFuncSetAttribute(MaxDynamicSharedMemorySize=%d) failed\n", LDS_BYTES);
    (void)hipOccupancyMaxActiveBlocksPerMultiprocessor(&per_cu, (const void*)mega, 512, LDS_BYTES);
    (void)hipGetLastError();
    grid_blocks = cus;
  }
  void* args[] = {&p};
  hipError_t err = hipLaunchCooperativeKernel((void*)mega, dim3(grid_blocks), dim3(512), args, LDS_BYTES, stream);
  if (err != hipSuccess) fprintf(stderr, "cooperative launch failed: %s (grid %d)\n", hipGetErrorString(err), grid_blocks);
}
```
